# Optimizing an MI355X kernel written in HIP

```python
import math
import jax, jax.numpy as jnp
from jax import lax
import numpy as np

D_MODEL = 2048
BATCH = 16
SEQ = 256
DEPTH = 2
DEC_BATCH = 4
DEC_SEQ = 1024
PAST_LEN = 512

GRID_W = 64
EPS = 1e-6
D_FF = 4 * D_MODEL

HG_HEADS = 8
HG_DK = 128
HG_DV = 128
HG_F = HG_HEADS * HG_DK
HG_V = HG_HEADS * HG_DV
HG_CHUNK = 16

CM_GROUPS = 8
CM_GROUP_DIM = 128
CM_W = CM_GROUPS * CM_GROUP_DIM
CM_CHUNK = 128

GDN_HEADS = 8
GDN_DK = 128
GDN_DV = 128
GDN_K = GDN_HEADS * GDN_DK
GDN_V = GDN_HEADS * GDN_DV
GDN_QKV = 2 * GDN_K + GDN_V
GDN_CHUNK = 64
CONV_K = 3

IN_SIZES = (HG_F, HG_V, HG_V, HG_F, HG_F,
            CM_W, CM_W,
            GDN_QKV, GDN_V, 2 * GDN_HEADS, 2 * GDN_HEADS,
            3 * D_MODEL)
IN_DIM = sum(IN_SIZES)

kernel_name = 'hybrid_hgrn2_gmlp_gdn_diffusion_step'


def rmsnorm(x, g):
    xf = x.astype(jnp.float32)
    y = xf * lax.rsqrt(jnp.mean(jnp.square(xf), axis=-1, keepdims=True) + EPS)
    return (y * g.astype(jnp.float32)).astype(x.dtype)


def l2norm(x):
    return x * lax.rsqrt(jnp.sum(jnp.square(x), axis=-1, keepdims=True) + EPS)


def rev(t):
    return jnp.flip(t, axis=1)


def hgrn2_scan(q, k, v, log_f, s0):
    B, L, H, DK = q.shape
    DV = v.shape[-1]
    C = HG_CHUNK
    N = L // C
    q, k, v, log_f = (t.reshape(B, N, C, H, t.shape[-1]) for t in (q, k, v, log_f))
    b = jnp.cumsum(log_f, axis=2)
    causal = jnp.tril(jnp.ones((C, C), dtype=bool))[:, :, None, None]
    decay = jnp.exp(jnp.where(causal, b[:, :, :, None] - b[:, :, None, :], -jnp.inf))
    scores = jnp.einsum('bntHd,bnsHd,bntsHd->bnHts', q, k, decay)
    o_intra = jnp.einsum('bnHts,bnsHv->bntHv', scores, v)
    b_last = b[:, :, -1]
    q_dec = q * jnp.exp(b)
    k_dec = k * jnp.exp(b_last[:, :, None] - b)

    def step(S, xs):
        qd, kd, vv, bl = xs
        o = jnp.einsum('bcHd,bHdv->bcHv', qd, S)
        S = S * jnp.exp(bl)[..., None] + jnp.einsum('bcHd,bcHv->bHdv', kd, vv)
        return S, o

    xs = tuple(jnp.moveaxis(t, 1, 0) for t in (q_dec, k_dec, v, b_last))
    s_T, o_inter = lax.scan(step, s0.astype(jnp.float32), xs)
    o = o_intra + jnp.moveaxis(o_inter, 0, 1)
    return o.reshape(B, L, H, DV), s_T


def gdn_scan(q, k, v, g, beta, s0):
    B, L, H, DK = q.shape
    DV = v.shape[-1]
    C = GDN_CHUNK
    N = L // C
    to_chunks = lambda t: jnp.moveaxis(t.reshape((B, N, C) + t.shape[2:]), 3, 2)
    q, k, v, g, beta = (to_chunks(t) for t in (q, k, v, g, beta))
    gc = jnp.cumsum(g, axis=-1)
    idx = jnp.arange(C)
    lower_incl = idx[:, None] >= idx[None, :]
    strict = idx[:, None] > idx[None, :]
    decay = jnp.exp(jnp.where(lower_incl, gc[..., :, None] - gc[..., None, :], -jnp.inf))
    kb = k * beta[..., None]
    m = jnp.where(strict, jnp.einsum('bnhtd,bnhsd->bnhts', kb, k) * decay, 0.0)
    eye = jnp.broadcast_to(jnp.eye(C, dtype=m.dtype), m.shape)
    T = lax.linalg.triangular_solve(m, eye, left_side=True, lower=True, unit_diagonal=True)
    u = T @ (v * beta[..., None])
    w = T @ (kb * jnp.exp(gc)[..., None])
    attn = jnp.einsum('bnhtd,bnhsd->bnhts', q, k) * decay
    q_dec = q * jnp.exp(gc)[..., None]
    g_last = gc[..., -1]
    k_dec = k * jnp.exp(g_last[..., None] - gc)[..., None]

    def step(S, xs):
        qd, kd, uu, ww, at, gl = xs
        v_new = uu - jnp.einsum('bhcd,bhdv->bhcv', ww, S)
        o = jnp.einsum('bhcd,bhdv->bhcv', qd, S) + jnp.einsum('bhts,bhsv->bhtv', at, v_new)
        S = S * jnp.exp(gl)[..., None, None] + jnp.einsum('bhcd,bhcv->bhdv', kd, v_new)
        return S, o

    xs = tuple(jnp.moveaxis(t, 1, 0) for t in (q_dec, k_dec, u, w, attn, g_last))
    s_T, o = lax.scan(step, s0.astype(jnp.float32), xs)
    o = jnp.moveaxis(jnp.moveaxis(o, 0, 1), 2, 3).reshape(B, L, H, DV)
    return o, s_T


def hgrn2_branch(q_raw, i_raw, g_raw, ff_raw, fb_raw, lb, onorm_g, s0):
    B, L, _ = q_raw.shape
    heads = lambda t, d: t.reshape(B, L, HG_HEADS, d)
    q = heads(jax.nn.silu(q_raw.astype(jnp.float32)), HG_DK)
    v = heads(i_raw.astype(jnp.float32), HG_DV)

    def gates(z, lbd):
        f = lbd + (1.0 - lbd) * jax.nn.sigmoid(z.astype(jnp.float32))
        return heads(1.0 - f, HG_DK), heads(jnp.log(f), HG_DK)

    k_f, lf_f = gates(ff_raw, lb[0])
    k_b, lf_b = gates(fb_raw, lb[1])
    o_f, s_f = hgrn2_scan(q, k_f, v, lf_f, s0[:, 0])
    o_b, s_b = hgrn2_scan(rev(q), rev(k_b), rev(v), rev(lf_b), s0[:, 1])
    o = rmsnorm(o_f + rev(o_b), onorm_g).reshape(B, L, HG_V) * jax.nn.silu(g_raw.astype(jnp.float32))
    return o.astype(q_raw.dtype), jnp.stack([s_f, s_b], axis=1)


def chunk_mlp_branch(u_raw, v_raw, vnorm_g, ws, bs):
    B, L, _ = u_raw.shape
    N = L // CM_CHUNK
    u = jax.nn.gelu(u_raw, approximate=False)
    v = jax.nn.gelu(v_raw, approximate=False).reshape(B, L, CM_GROUPS, CM_GROUP_DIM)
    v = rmsnorm(v, vnorm_g.reshape(CM_GROUPS, CM_GROUP_DIM)).reshape(B, N, CM_CHUNK, CM_GROUPS, CM_GROUP_DIM)
    s = jnp.einsum('gpq,bnqgc->bnpgc', ws, v) + bs.T[:, :, None]
    return u * s.reshape(B, L, CM_W)


def short_conv(x, w, rows):
    B, L, Cc = x.shape
    p = CONV_K // 2
    if rows is not None:
        y = lax.conv_general_dilated(x.reshape(B, rows, GRID_W, Cc), w[:, :, None, :].astype(x.dtype),
                                     (1, 1), [(p, p), (p, p)], dimension_numbers=('NHWC', 'HWIO', 'NHWC'),
                                     feature_group_count=Cc)
        return y.reshape(B, L, Cc)
    return lax.conv_general_dilated(x, w[p][:, None, :].astype(x.dtype), (1,), [(p, p)],
                                    dimension_numbers=('NWC', 'WIO', 'NWC'), feature_group_count=Cc)


def gdn_branch(qkv_raw, g_raw, a_raw, b_raw, conv_w, A_log, dt_bias, onorm_g, s0, rows):
    B, L, _ = qkv_raw.shape
    qkv = jax.nn.silu(short_conv(qkv_raw, conv_w, rows).astype(jnp.float32))
    q, k, v = jnp.split(qkv, [GDN_K, 2 * GDN_K], axis=-1)
    q = l2norm(q.reshape(B, L, GDN_HEADS, GDN_DK)) * (GDN_DK ** -0.5)
    k = l2norm(k.reshape(B, L, GDN_HEADS, GDN_DK))
    v = v.reshape(B, L, GDN_HEADS, GDN_DV)
    a = a_raw.astype(jnp.float32).reshape(B, L, 2, GDN_HEADS)
    g = -jnp.exp(A_log.astype(jnp.float32)) * jax.nn.softplus(a + dt_bias.astype(jnp.float32))
    beta = jax.nn.sigmoid(b_raw.astype(jnp.float32).reshape(B, L, 2, GDN_HEADS))
    o_f, s_f = gdn_scan(q, k, v, g[:, :, 0], beta[:, :, 0], s0[:, 0])
    o_b, s_b = gdn_scan(rev(q), rev(k), rev(v), rev(g[:, :, 1]), rev(beta[:, :, 1]), s0[:, 1])
    o = rmsnorm(o_f + rev(o_b), onorm_g).reshape(B, L, GDN_V) * jax.nn.silu(g_raw.astype(jnp.float32))
    return o.astype(qkv_raw.dtype), jnp.stack([s_f, s_b], axis=1)


def block(x, mod, p, lb, s0_hg, s0_gdn, rows):
    shift1, scale1, gate1, shift2, scale2, gate2 = jnp.split(mod, 6, axis=-1)
    h = rmsnorm(x, p['norm1_g']) * (1.0 + scale1) + shift1
    (hq, hi, hgo, hff, hfb, cu, cv, gqkv, ggo, ga, gbeta, gates) = jnp.split(
        h @ p['w_in'], np.cumsum(IN_SIZES)[:-1].tolist(), axis=-1)
    o_a, s_hg = hgrn2_branch(hq, hi, hgo, hff, hfb, lb, p['hg_onorm_g'], s0_hg)
    o_b = chunk_mlp_branch(cu, cv, p['cm_vnorm_g'], p['cm_ws'], p['cm_bs'])
    o_c, s_gdn = gdn_branch(gqkv, ggo, ga, gbeta, p['gdn_conv'], p['gdn_A_log'], p['gdn_dt_bias'],
                            p['gdn_onorm_g'], s0_gdn, rows)
    g_a, g_b, g_c = jnp.split(jax.nn.sigmoid(gates), 3, axis=-1)
    merged = (g_a * (o_a @ p['w_br_hg']) + g_b * (o_b @ p['w_br_cm']) + g_c * (o_c @ p['w_br_gdn']))
    x = x + gate1 * (merged @ p['w_out'])
    h2 = rmsnorm(x, p['norm2_g']) * (1.0 + scale2) + shift2
    x = x + gate2 * (jnp.square(jax.nn.relu(h2 @ p['w_ff1'])) @ p['w_ff2'])
    return x, s_hg, s_gdn


def setup_inputs(seed: int = 0) -> dict:
    key = jax.random.key(seed)
    ks = iter(jax.random.split(key, 40))
    f32 = jnp.float32
    D = D_MODEL

    def nrm(shape, scale):
        return jax.random.normal(next(ks), shape, f32) * scale

    x_prompt = nrm((BATCH, SEQ, D), 1.0)
    x_sample = nrm((DEC_BATCH, DEC_SEQ, D), 1.0)
    c = nrm((DEC_BATCH, D), 1.0)
    state_hgrn = nrm((DEC_BATCH, DEPTH, 2, HG_HEADS, HG_DK, HG_DV), 0.5)
    state_gdn = nrm((DEC_BATCH, DEPTH, 2, GDN_HEADS, GDN_DK, GDN_DV), 0.1)
    c_ctx = nrm((D,), 1.0)
    norm1_g = 1.0 + nrm((DEPTH, D), 0.02)
    norm2_g = 1.0 + nrm((DEPTH, D), 0.02)
    w_mod = nrm((DEPTH, D, 6 * D), D ** -0.5)
    b_mod = nrm((DEPTH, 6 * D), 0.02)
    w_in = nrm((DEPTH, D, IN_DIM), D ** -0.5)
    hg_lb = nrm((DEPTH, 2, HG_F), 1.0)
    hg_onorm_g = 1.0 + nrm((DEPTH, HG_DV), 0.02)
    cm_vnorm_g = 1.0 + nrm((DEPTH, CM_W), 0.02)
    cm_ws = nrm((DEPTH, CM_GROUPS, CM_CHUNK, CM_CHUNK), CM_CHUNK ** -0.5)
    cm_bs = 1.0 + nrm((DEPTH, CM_GROUPS, CM_CHUNK), 0.02)
    gdn_conv = nrm((DEPTH, CONV_K, CONV_K, GDN_QKV), 0.5)
    gdn_A_log = jnp.log(jax.random.uniform(next(ks), (DEPTH, 2, GDN_HEADS), f32, 1.0, 16.0))
    dt = jnp.exp(jax.random.uniform(next(ks), (DEPTH, 2, GDN_HEADS), f32, math.log(1e-3), math.log(1e-1)))
    gdn_dt_bias = dt + jnp.log(-jnp.expm1(-dt))
    gdn_onorm_g = 1.0 + nrm((DEPTH, GDN_DV), 0.02)
    w_br_hg = nrm((DEPTH, HG_V, D), HG_V ** -0.5)
    w_br_cm = nrm((DEPTH, CM_W, D), CM_W ** -0.5)
    w_br_gdn = nrm((DEPTH, GDN_V, D), GDN_V ** -0.5)
    w_out = nrm((DEPTH, D, D), D ** -0.5)
    w_ff1 = nrm((DEPTH, D, D_FF), D ** -0.5)
    w_ff2 = nrm((DEPTH, D_FF, D), D_FF ** -0.5)
    final_g = 1.0 + nrm((D,), 0.02)
    return {'x_prompt': x_prompt, 'x_sample': x_sample, 'c': c,
            'state_hgrn': state_hgrn, 'state_gdn': state_gdn, 'c_ctx': c_ctx,
            'norm1_g': norm1_g, 'norm2_g': norm2_g, 'w_mod': w_mod, 'b_mod': b_mod, 'w_in': w_in,
            'hg_lb': hg_lb, 'hg_onorm_g': hg_onorm_g, 'cm_vnorm_g': cm_vnorm_g, 'cm_ws': cm_ws,
            'cm_bs': cm_bs, 'gdn_conv': gdn_conv, 'gdn_A_log': gdn_A_log, 'gdn_dt_bias': gdn_dt_bias,
            'gdn_onorm_g': gdn_onorm_g, 'w_br_hg': w_br_hg, 'w_br_cm': w_br_cm, 'w_br_gdn': w_br_gdn,
            'w_out': w_out, 'w_ff1': w_ff1, 'w_ff2': w_ff2, 'final_g': final_g}


def reference(x_prompt, x_sample, c, state_hgrn, state_gdn, c_ctx, norm1_g, norm2_g, w_mod, b_mod, w_in,
              hg_lb, hg_onorm_g, cm_vnorm_g, cm_ws, cm_bs, gdn_conv, gdn_A_log, gdn_dt_bias, gdn_onorm_g,
              w_br_hg, w_br_cm, w_br_gdn, w_out, w_ff1, w_ff2, final_g):
    lb_all = jnp.cumsum(jax.nn.softmax(hg_lb.astype(jnp.float32), axis=0), axis=0)
    lb_all = lb_all - lb_all[:1]
    rows = x_sample.shape[1] // GRID_W
    n_ctx = x_prompt.shape[0]
    zeros_hg = jnp.zeros((n_ctx, 2, HG_HEADS, HG_DK, HG_DV), jnp.float32)
    zeros_gdn = jnp.zeros((n_ctx, 2, GDN_HEADS, GDN_DK, GDN_DV), jnp.float32)
    xp = x_prompt
    xs = x_sample
    new_hg = []
    new_gdn = []
    for l in range(DEPTH):
        p = dict(norm1_g=norm1_g[l], norm2_g=norm2_g[l], w_in=w_in[l], hg_onorm_g=hg_onorm_g[l],
                 cm_vnorm_g=cm_vnorm_g[l], cm_ws=cm_ws[l], cm_bs=cm_bs[l], gdn_conv=gdn_conv[l],
                 gdn_A_log=gdn_A_log[l], gdn_dt_bias=gdn_dt_bias[l], gdn_onorm_g=gdn_onorm_g[l],
                 w_br_hg=w_br_hg[l], w_br_cm=w_br_cm[l], w_br_gdn=w_br_gdn[l], w_out=w_out[l],
                 w_ff1=w_ff1[l], w_ff2=w_ff2[l])
        mod_ctx = (jax.nn.silu(c_ctx) @ w_mod[l] + b_mod[l])[None, None, :]
        mod_lat = (jax.nn.silu(c) @ w_mod[l] + b_mod[l])[:, None, :]
        xp, s_hg, s_gdn = block(xp, mod_ctx, p, lb_all[l], zeros_hg, zeros_gdn, None)
        new_hg.append(s_hg)
        new_gdn.append(s_gdn)
        xs, _, _ = block(xs, mod_lat, p, lb_all[l], state_hgrn[:, l], state_gdn[:, l], rows)
    y_prompt = rmsnorm(xp, final_g)
    y_sample = rmsnorm(xs, final_g)
    new_state_hgrn = jnp.stack(new_hg, axis=1).astype(x_prompt.dtype)
    new_state_gdn = jnp.stack(new_gdn, axis=1).astype(x_prompt.dtype)
    return (y_prompt, y_sample, new_state_hgrn, new_state_gdn)
```

```cpp
#include <hip/hip_runtime.h>
#include <hip/hip_cooperative_groups.h>
#include <cstdio>
#include <cstdint>
namespace cg = cooperative_groups;
namespace pg8 {
#define PG8_LAS __attribute__((address_space(3)))
typedef unsigned short bf16_t;
typedef short bf16x8 __attribute__((ext_vector_type(8)));
typedef float f32x4 __attribute__((ext_vector_type(4)));
typedef unsigned u32x4 __attribute__((ext_vector_type(4)));
constexpr int BM = 256, BK = 64, HALF = 128, HTB = HALF * BK * 2  , STAGE_BYTES = 8 * HTB, NXCD = 8, WGM = 8;

__host__ __device__ __forceinline__ int lds_byte(int r, int c) { const int st = (r >> 4) * 2 + (c >> 5), rr = r & 15, cc = c & 31, ob = rr * 64 + cc * 2; return st * 1024 + (ob ^ (((ob >> 9) & 1) << 5)); }
__host__ __device__ __forceinline__ void stage_rc(int b, int& R, int& C) { const int st = b / 1024, sb = b % 1024, swz = sb ^ (((sb >> 9) & 1) << 5); R = (st >> 1) * 16 + swz / 64; C = (st & 1) * 32 + (swz % 64) / 2; }
__host__ __device__ __forceinline__ int perm32(int rho) { const int n = rho >> 4, i = rho & 15; return 8 * (i >> 2) + 4 * n + (i & 3); }

struct Unit { int pm, pn; };
struct Gemm { const bf16_t* A; const bf16_t* Bt; int M, N, K; };

struct StaticOrder {
    int nM, nN, nwg, G, c;
    __host__ __device__ void init(int M, int N, int G_, int c_) { nM = M / BM; nN = N / BM; nwg = nM * nN; G = G_; c = c_; }
    __host__ __device__ bool next(int i, Unit& u) const {
        const long L = (long)i * G + c; if (L >= nwg) return false;
        int wgid = (int)L; { const int q = nwg / NXCD, r = nwg % NXCD, xcd = wgid % NXCD, off = wgid / NXCD; wgid = (xcd < r ? xcd * (q + 1) : r * (q + 1) + (xcd - r) * q) + off; }
        const int nig = WGM * nN, gid = wgid / nig, fm = gid * WGM, gsz = (nM - fm) < WGM ? (nM - fm) : WGM;
        u.pm = fm + ((wgid % nig) % gsz); u.pn = (wgid % nig) / gsz; return true;
    }
    __device__ __forceinline__ void a_ready(const Unit&) const {}
    __device__ __forceinline__ void done(const Unit&) const {}
};

__device__ __forceinline__ unsigned cvt_pk_bf16(float lo, float hi) { unsigned r; asm volatile("v_cvt_pk_bf16_f32 %0, %1, %2" : "=v"(r) : "v"(lo), "v"(hi)); return r; }
template <class Epi, class Sched, bool ALIGN_EPI = false, bool SP2 = false>
__device__ __forceinline__ void gemm_phase(PG8_LAS unsigned char* lds, const Gemm g, const Sched& S, const Epi& E) {
    int tid_o = threadIdx.x; asm volatile("" : "+v"(tid_o)); const int tid = tid_o, wid = __builtin_amdgcn_readfirstlane(tid >> 6), lane = tid & 63, wr = wid >> 2, wc = wid & 3, fr = lane & 15, fq = lane >> 4;
    const int K = g.K, nt = K / BK;
    unsigned voffA[2], voffB[2];
#pragma unroll
    for (int i = 0; i < 2; ++i) { int R, C; stage_rc(tid * 16 + i * 8192, R, C); const int Rb = Epi::PERM ? ((R & ~31) + perm32(R & 31)) : R;
        voffA[i] = (unsigned)(R * K + C) * 2u; voffB[i] = (unsigned)(Rb * K + C) * 2u; }
    const size_t kstep = (size_t)(BK * 2);
    const size_t hstep = (size_t)HALF * K * 2;
    const size_t tstep = 2 * hstep;
    const unsigned ldsw = (unsigned)wid * 1024u;
    const int aoff = lds_byte(wr * 64 + fr, fq * 8), boff = lds_byte(wc * 32 + fr, fq * 8);
#define PG8_SA(b, h) (((b) * 2 + (h)) * HTB)
#define PG8_SB(b, h) ((4 + (b) * 2 + (h)) * HTB)
#define PG8_STAGE(bufoff, gbase, voff) do { _Pragma("unroll") for (int _i = 0; _i < 2; ++_i) \
        __builtin_amdgcn_global_load_lds((const unsigned*)((const char*)(gbase) + (voff)[_i]), (PG8_LAS unsigned*)(lds + (bufoff) + ldsw + _i * 8192), 16, 0, 0); } while (0)
#define PG8_LDA(dst, b, h) do { _Pragma("unroll") for (int m = 0; m < 4; ++m) _Pragma("unroll") for (int k = 0; k < 2; ++k) dst[m][k] = *(const PG8_LAS bf16x8*)(lds + PG8_SA(b, h) + aoff + m * 2048 + k * 1024); } while (0)
#define PG8_LDB(dst, b, h) do { _Pragma("unroll") for (int n = 0; n < 2; ++n) _Pragma("unroll") for (int k = 0; k < 2; ++k) dst[n][k] = *(const PG8_LAS bf16x8*)(lds + PG8_SB(b, h) + boff + n * 2048 + k * 1024); } while (0)
#define PG8_MMA(ai, bj, At, Bt) do { __builtin_amdgcn_s_setprio(1); _Pragma("unroll") for (int m = 0; m < 4; ++m) _Pragma("unroll") for (int n = 0; n < 2; ++n) _Pragma("unroll") for (int k = 0; k < 2; ++k) \
        acc[ai][bj][m][n] = __builtin_amdgcn_mfma_f32_16x16x32_bf16(Bt[n][k], At[m][k], acc[ai][bj][m][n], 0, 0, 0); __builtin_amdgcn_s_setprio(0); } while (0)
#define PG8_WAIT_V(n) asm volatile("s_waitcnt vmcnt(" #n ")" ::: "memory")
#define PG8_WAIT_L(n) asm volatile("s_waitcnt lgkmcnt(" #n ")" ::: "memory")
#define PG8_BAR __builtin_amdgcn_s_barrier()
#define PG8_SCHED __builtin_amdgcn_sched_barrier(0)
    Unit cur, nxt; int ui = 0;
    if (!S.next(0, cur)) return;
    f32x4 acc[2][2][4][2];
#pragma unroll
    for (int a = 0; a < 2; ++a)
#pragma unroll
        for (int b = 0; b < 2; ++b)
#pragma unroll
            for (int m = 0; m < 4; ++m)
#pragma unroll
                for (int n = 0; n < 2; ++n) acc[a][b][m][n] = (f32x4){0.f, 0.f, 0.f, 0.f};
    bf16x8 At[4][2], B0[2][2], B1[2][2];
    const char* cA = (const char*)g.A + (size_t)cur.pm * tstep; const char* cB = (const char*)g.Bt + (size_t)cur.pn * tstep;
    S.a_ready(cur);
    if constexpr (SP2) {
        PG8_STAGE(PG8_SB(0, 0), cB, voffB); PG8_STAGE(PG8_SB(0, 1), cB + hstep, voffB); PG8_STAGE(PG8_SA(0, 0), cA, voffA); PG8_STAGE(PG8_SA(0, 1), cA + hstep, voffA);
        if (wr == 1) PG8_BAR;
        PG8_WAIT_V(2); PG8_BAR;
        PG8_STAGE(PG8_SB(1, 0), cB + kstep, voffB); PG8_STAGE(PG8_SA(1, 0), cA + kstep, voffA); PG8_STAGE(PG8_SB(1, 1), cB + hstep + kstep, voffB);
        PG8_WAIT_V(6); PG8_BAR;
    } else {
        PG8_STAGE(PG8_SB(0, 0), cB, voffB); PG8_STAGE(PG8_SA(0, 0), cA, voffA); PG8_STAGE(PG8_SB(0, 1), cB + hstep, voffB); PG8_STAGE(PG8_SA(0, 1), cA + hstep, voffA);
        if (wr == 1) PG8_BAR;
        PG8_WAIT_V(4); PG8_BAR;
        PG8_STAGE(PG8_SB(1, 0), cB + kstep, voffB); PG8_STAGE(PG8_SA(1, 0), cA + kstep, voffA); PG8_STAGE(PG8_SB(1, 1), cB + hstep + kstep, voffB);
        PG8_WAIT_V(6); PG8_BAR;
    }
    for (;;) {
        const bool has_next = S.next(ui + 1, nxt);
        const char* nA = has_next ? (const char*)g.A + (size_t)nxt.pm * tstep : cA; const char* nB = has_next ? (const char*)g.Bt + (size_t)nxt.pn * tstep : cB;
        for (int t = 0; t < nt; t += 2) {
            const bool last = (t == nt - 2);
            const char* a1 = cA + (size_t)(t + 1) * kstep;
            const char* a2 = last ? nA : cA + (size_t)(t + 2) * kstep; const char* b2 = last ? nB : cB + (size_t)(t + 2) * kstep;
            const char* a3 = a2 + kstep; const char* b3 = b2 + kstep;
            if (last && has_next) S.a_ready(nxt);
            if constexpr (SP2) {
            PG8_LDB(B0, 0, 0); PG8_LDB(B1, 0, 1); PG8_SCHED; PG8_LDA(At, 0, 0); PG8_STAGE(PG8_SA(1, 1), a1 + hstep, voffA);
            PG8_WAIT_V(8); PG8_WAIT_L(0); PG8_BAR; PG8_MMA(0, 0, At, B0); PG8_MMA(0, 1, At, B1); PG8_BAR; PG8_SCHED;
            PG8_LDA(At, 0, 1); PG8_STAGE(PG8_SB(0, 0), b2, voffB); PG8_STAGE(PG8_SB(0, 1), b2 + hstep, voffB); PG8_STAGE(PG8_SA(0, 0), a2, voffA);
            PG8_WAIT_V(8); PG8_WAIT_L(0); PG8_BAR; PG8_MMA(1, 0, At, B0); PG8_MMA(1, 1, At, B1); PG8_BAR; PG8_SCHED;
            PG8_LDB(B0, 1, 0); PG8_LDB(B1, 1, 1); PG8_SCHED; PG8_LDA(At, 1, 0); PG8_STAGE(PG8_SA(0, 1), a2 + hstep, voffA);
            PG8_WAIT_V(8); PG8_WAIT_L(0); PG8_BAR; PG8_MMA(0, 0, At, B0); PG8_MMA(0, 1, At, B1); PG8_BAR; PG8_SCHED;
            PG8_LDA(At, 1, 1); PG8_STAGE(PG8_SB(1, 0), b3, voffB); PG8_STAGE(PG8_SB(1, 1), b3 + hstep, voffB); PG8_STAGE(PG8_SA(1, 0), a3, voffA);
            PG8_WAIT_V(8); PG8_WAIT_L(0); PG8_BAR; PG8_MMA(1, 0, At, B0); PG8_MMA(1, 1, At, B1); PG8_BAR; PG8_SCHED;
            } else {
            PG8_LDB(B0, 0, 0); PG8_SCHED; PG8_LDA(At, 0, 0); PG8_STAGE(PG8_SA(1, 1), a1 + hstep, voffA);
            PG8_WAIT_L(8); PG8_BAR; PG8_WAIT_L(0); PG8_MMA(0, 0, At, B0); PG8_BAR; PG8_SCHED;
            PG8_LDB(B1, 0, 1); PG8_STAGE(PG8_SB(0, 0), b2, voffB);
            PG8_BAR; PG8_WAIT_L(0); PG8_MMA(0, 1, At, B1); PG8_BAR;
            PG8_LDA(At, 0, 1); PG8_STAGE(PG8_SA(0, 0), a2, voffA);
            PG8_BAR; PG8_WAIT_L(0); PG8_MMA(1, 0, At, B0); PG8_BAR; PG8_SCHED;
            PG8_STAGE(PG8_SB(0, 1), b2 + hstep, voffB);
            PG8_WAIT_V(6); PG8_BAR; PG8_MMA(1, 1, At, B1); PG8_BAR;
            PG8_LDB(B0, 1, 0); PG8_SCHED; PG8_LDA(At, 1, 0); PG8_STAGE(PG8_SA(0, 1), a2 + hstep, voffA);
            PG8_WAIT_L(8); PG8_BAR; PG8_WAIT_L(0); PG8_MMA(0, 0, At, B0); PG8_BAR; PG8_SCHED;
            PG8_LDB(B1, 1, 1); PG8_STAGE(PG8_SB(1, 0), b3, voffB);
            PG8_BAR; PG8_WAIT_L(0); PG8_MMA(0, 1, At, B1); PG8_BAR;
            PG8_LDA(At, 1, 1); PG8_STAGE(PG8_SA(1, 0), a3, voffA);
            PG8_BAR; PG8_WAIT_L(0); PG8_MMA(1, 0, At, B0); PG8_BAR; PG8_SCHED;
            PG8_STAGE(PG8_SB(1, 1), b3 + hstep, voffB);
            PG8_WAIT_V(6); PG8_BAR; PG8_MMA(1, 1, At, B1); PG8_BAR;
            }
        }
        if constexpr (ALIGN_EPI) { if (wr == 0) PG8_BAR; }
        if constexpr (!Epi::AFTER_DRAIN) { E(acc, cur, wr, wc, fr, fq); S.done(cur); }
        if (!has_next) break;
#pragma unroll
        for (int a = 0; a < 2; ++a)
#pragma unroll
            for (int b = 0; b < 2; ++b)
#pragma unroll
                for (int m = 0; m < 4; ++m)
#pragma unroll
                    for (int n = 0; n < 2; ++n) acc[a][b][m][n] = (f32x4){0.f, 0.f, 0.f, 0.f};
        cur = nxt; cA = nA; cB = nB; ++ui;
        if constexpr (ALIGN_EPI) { if (wr == 1) PG8_BAR; }
    }
    PG8_WAIT_V(0);
    if constexpr (!ALIGN_EPI) { if (wr == 0) PG8_BAR; }
    PG8_BAR;
    if constexpr (Epi::AFTER_DRAIN) { E.fused(acc, cur, wr, wc, fr, fq, lds, wid, lane); S.done(cur); }
#undef PG8_SA
#undef PG8_SB
#undef PG8_STAGE
#undef PG8_LDA
#undef PG8_LDB
#undef PG8_MMA
#undef PG8_WAIT_V
#undef PG8_WAIT_L
#undef PG8_BAR
#undef PG8_SCHED
}
}


#ifndef MK_MULTI
#define MK_MULTI 1
#endif
#define LAS __attribute__((address_space(3)))
typedef unsigned short bf16_t;
typedef float f32x4 __attribute__((ext_vector_type(4)));
typedef float f32x2 __attribute__((ext_vector_type(2)));
typedef unsigned u32x4 __attribute__((ext_vector_type(4)));
typedef unsigned u32x2 __attribute__((ext_vector_type(2)));
typedef short bf16x8 __attribute__((ext_vector_type(8)));

constexpr int D = 2048, NTOK = 8192, NCTX = 4096, IN_DIM = 17440, IN_PAD = 17664, DFF = 8192;
constexpr int NTHR = 512;
constexpr float EPS = 1e-6f;
constexpr size_t MiB = 1u << 20;
constexpr size_t WS_CTL = 0, CTL_BYTES = 1 * MiB;
constexpr size_t WS_MOD = 1 * MiB;
constexpr size_t WS_W = 2 * MiB, W_LSTRIDE = 153 * MiB;
constexpr size_t W_IN = 0, W_BR = 69 * MiB, W_OUT = 81 * MiB, W_FF1 = 89 * MiB, W_FF2 = 121 * MiB;
constexpr size_t WS_X = 308 * MiB;
constexpr size_t WS_H = 372 * MiB;
constexpr size_t WS_FF = 404 * MiB, WS_FB = 436 * MiB;
constexpr size_t WS_HQ = 468 * MiB, WS_HI = 484 * MiB, WS_HGO = 500 * MiB, WS_CU = 516 * MiB, WS_CV = 532 * MiB;
constexpr size_t WS_GQKV = 548 * MiB;
constexpr size_t WS_GGO = 596 * MiB;
constexpr size_t WS_GATES = 612 * MiB;
constexpr size_t WS_GAB = 708 * MiB;
constexpr size_t WS_GQ = 709 * MiB, WS_GK = 741 * MiB, WS_GV = 773 * MiB;
constexpr size_t WS_OA = 805 * MiB, WS_OB = 821 * MiB, WS_OC = 837 * MiB;
constexpr size_t WS_END = 853 * MiB;
constexpr size_t WS_OSH = WS_H;
constexpr size_t WS_OSG = WS_GQKV;
constexpr size_t WS_FFH = WS_FF;
constexpr size_t WS_T32 = WS_GQ;
constexpr size_t WS_MERGED = WS_GV;
constexpr int CW_QUEUE = 64;
constexpr int CW_BAR = 4096;
constexpr int LDS_MISC = 131072, LDS_BYTES = 131072 + 512;
constexpr size_t OUT_Y = 0, OUT_SHG = (size_t)NTOK * D, OUT_SGDN = OUT_SHG + (size_t)16 * 2 * 2 * 8 * 16384;
constexpr int N_PHASES = 22;

__device__ __forceinline__ int otid() { int t = threadIdx.x; asm volatile("" : "+v"(t)); return t; }
__device__ __forceinline__ int obid() { int t = blockIdx.x; asm volatile("" : "+s"(t)); return t; }
struct Args { const float* in[27]; float* out; unsigned char* ws; int ph_lo, ph_hi; };
typedef const Args __attribute__((address_space(4))) KArgs;
__device__ __forceinline__ KArgs* get_args() { KArgs* p = (KArgs*)__builtin_amdgcn_kernarg_segment_ptr(); asm volatile("" : "+s"(p)); return p; }

__device__ __forceinline__ unsigned f2bf(float f) { unsigned u = __builtin_bit_cast(unsigned, f); return (u + 0x7fffu + ((u >> 16) & 1u)) >> 16; }
__device__ __forceinline__ unsigned pk2(float lo, float hi) { return f2bf(lo) | (f2bf(hi) << 16); }
__device__ __forceinline__ float bf_lo(unsigned w) { return __builtin_bit_cast(float, w << 16); }
__device__ __forceinline__ float bf_hi(unsigned w) { return __builtin_bit_cast(float, w & 0xffff0000u); }
__device__ __forceinline__ float wave_sum(float v) {
#pragma unroll
    for (int o = 1; o < 64; o <<= 1) v += __shfl_xor(v, o);
    return v;
}
__device__ __forceinline__ float sigmoidf_(float x) { return 1.0f / (1.0f + __expf(-x)); }
__device__ __forceinline__ float siluf_(float x) { return x / (1.0f + __expf(-x)); }
__device__ __forceinline__ float geluf_(float x) { return 0.5f * x * (1.0f + erff(x * 0.70710678118f)); }
__device__ __forceinline__ float dpp_f(float x, const int ctrl_unused) { return x; }
__device__ __forceinline__ float red8(float x) {
    int t;
    t = __builtin_amdgcn_update_dpp(0, __builtin_bit_cast(int, x), 0xB1, 0xF, 0xF, false); x += __builtin_bit_cast(float, t);
    t = __builtin_amdgcn_update_dpp(0, __builtin_bit_cast(int, x), 0x4E, 0xF, 0xF, false); x += __builtin_bit_cast(float, t);
    t = __builtin_amdgcn_update_dpp(0, __builtin_bit_cast(int, x), 0x141, 0xF, 0xF, false); x += __builtin_bit_cast(float, t);
    return x;
}

__device__ __forceinline__ void p0_transpose_item(const float* W, int K, int N, bf16_t* WT, int item, LAS float* scr, int lane, bool remap_in) {
    const int nblk = N / 32, kb = item / nblk, nb = item % nblk, k0 = 64 * kb, n0 = 32 * nb;
    int drow0 = n0;
    if (remap_in) drow0 = (n0 < 11264) ? n0 : ((n0 < 11296) ? 17408 : n0 - 32);
#pragma unroll 8
    for (int i = 0; i < 32; ++i) { const int kk = 2 * i + (lane >> 5); scr[kk * 33 + (lane & 31)] = W[(size_t)(k0 + kk) * N + n0 + (lane & 31)]; }
    asm volatile("s_waitcnt lgkmcnt(0)" ::: "memory");
    const int c = lane & 7;
#pragma unroll
    for (int j = 0; j < 4; ++j) { const int n = (lane >> 3) + 8 * j; const LAS float* s = scr + (8 * c) * 33 + n;
        u32x4 o; o.x = pk2(s[0 * 33], s[1 * 33]); o.y = pk2(s[2 * 33], s[3 * 33]); o.z = pk2(s[4 * 33], s[5 * 33]); o.w = pk2(s[6 * 33], s[7 * 33]);
        *(u32x4*)(WT + (size_t)(drow0 + n) * K + k0 + 8 * c) = o; }
    asm volatile("s_waitcnt lgkmcnt(0)" ::: "memory");
}

__device__ __forceinline__ void phase_prologue(KArgs& a, LAS unsigned char* lds) {
    const int tid = otid(), lane = tid & 63, wave = tid >> 6, G = gridDim.x;
    float* MOD = (float*)(a.ws + WS_MOD);
    LAS float* sc = (LAS float*)lds;
    LAS float* red = (LAS float*)(lds + 40960);
    for (int i = tid; i < 5 * 2048; i += NTHR) { const int v = i >> 11, k = i & 2047; const float x = (v == 0) ? a.in[5][k] : a.in[2][(v - 1) * 2048 + k]; sc[i] = siluf_(x); }
    __syncthreads();
    for (int chunk = blockIdx.x; chunk < 256; chunk += G) {
        const int l = chunk >> 7, n0 = (chunk & 127) * 96;
        if (tid < 384) {
            const int kg = tid / 24, ln = tid % 24;
            const float* W = a.in[8] + ((size_t)l * 2048 + kg * 128) * 12288 + n0 + 4 * ln;
            f32x4 acc[5];
#pragma unroll
            for (int v = 0; v < 5; ++v) acc[v] = (f32x4){0.f, 0.f, 0.f, 0.f};
#pragma unroll 8
            for (int k = 0; k < 128; ++k) {
                const f32x4 w = *(const f32x4*)(W + (size_t)k * 12288);
#pragma unroll
                for (int v = 0; v < 5; ++v) { const float s = sc[v * 2048 + kg * 128 + k]; acc[v] += s * w; }
            }
#pragma unroll
            for (int v = 0; v < 5; ++v) *(LAS f32x4*)(red + (kg * 5 + v) * 96 + 4 * ln) = acc[v];
        }
        __syncthreads();
        if (tid < 480) { const int v = tid / 96, c = tid % 96; float s = 0.f;
#pragma unroll
            for (int kg = 0; kg < 16; ++kg) s += red[(kg * 5 + v) * 96 + c];
            MOD[(l * 5 + v) * 12288 + n0 + c] = s + a.in[9][l * 12288 + n0 + c]; }
        __syncthreads();
    }
    LAS float* scr = (LAS float*)(lds + wave * 16384);
    const int gw = blockIdx.x * 8 + wave, NGW = G * 8;
    constexpr int I_IN = 32 * 545, I_BR = 16 * 64, I_OUT = 32 * 64, I_F1 = 32 * 256, I_F2 = 128 * 64, I_L = I_IN + 3 * I_BR + I_OUT + I_F1 + I_F2;
    for (int it = gw; it < 2 * I_L; it += NGW) {
        const int l = it / I_L; int r = it - l * I_L;
        unsigned char* wl = a.ws + WS_W + (size_t)l * W_LSTRIDE;
        if (r < I_IN) { p0_transpose_item(a.in[10] + (size_t)l * 2048 * IN_DIM, 2048, IN_DIM, (bf16_t*)(wl + W_IN), r, scr, lane, true); continue; } r -= I_IN;
        if (r < I_BR) { p0_transpose_item(a.in[20] + (size_t)l * 1024 * 2048, 1024, 2048, (bf16_t*)(wl + W_BR), r, scr, lane, false); continue; } r -= I_BR;
        if (r < I_BR) { p0_transpose_item(a.in[21] + (size_t)l * 1024 * 2048, 1024, 2048, (bf16_t*)(wl + W_BR + 4 * MiB), r, scr, lane, false); continue; } r -= I_BR;
        if (r < I_BR) { p0_transpose_item(a.in[22] + (size_t)l * 1024 * 2048, 1024, 2048, (bf16_t*)(wl + W_BR + 8 * MiB), r, scr, lane, false); continue; } r -= I_BR;
        if (r < I_OUT) { p0_transpose_item(a.in[23] + (size_t)l * 2048 * 2048, 2048, 2048, (bf16_t*)(wl + W_OUT), r, scr, lane, false); continue; } r -= I_OUT;
        if (r < I_F1) { p0_transpose_item(a.in[24] + (size_t)l * 2048 * 8192, 2048, 8192, (bf16_t*)(wl + W_FF1), r, scr, lane, false); continue; } r -= I_F1;
        p0_transpose_item(a.in[25] + (size_t)l * 8192 * 2048, 8192, 2048, (bf16_t*)(wl + W_FF2), r, scr, lane, false);
    }
    for (int i = blockIdx.x * NTHR + tid; i < 2 * 57344; i += G * NTHR) { const int l = i / 57344, j = i - l * 57344;
        *(u32x4*)(a.ws + WS_W + (size_t)l * W_LSTRIDE + W_IN + (size_t)IN_DIM * 4096 + (size_t)j * 16) = (u32x4){0u, 0u, 0u, 0u}; }
}

__device__ __forceinline__ int mod_vec_of_row(int r) { return r < NCTX ? 0 : 1 + ((r - NCTX) >> 10); }

__device__ __forceinline__ void phase_norm_mod(KArgs& a, int l, int which) {
    const int tid = otid(), lane = tid & 63, wave = tid >> 6, gw = blockIdx.x * 8 + wave, NGW = gridDim.x * 8;
    float* X = (float*)(a.ws + WS_X); bf16_t* H = (bf16_t*)(a.ws + WS_H); const float* MOD = (const float*)(a.ws + WS_MOD);
    const bool first = (which == 0 && l == 0);
    const float* gvec = (which ? a.in[7] : a.in[6]) + l * 2048;
    for (int r = gw; r < NTOK; r += NGW) {
        const float* src = first ? (r < NCTX ? a.in[0] + (size_t)r * D : a.in[1] + (size_t)(r - NCTX) * D) : X + (size_t)r * D;
        f32x4 v[8]; float ss = 0.f;
#pragma unroll
        for (int j = 0; j < 8; ++j) { v[j] = ((const f32x4*)src)[64 * j + lane]; ss += (v[j].x * v[j].x + v[j].y * v[j].y) + (v[j].z * v[j].z + v[j].w * v[j].w); }
        const float rstd = rsqrtf(wave_sum(ss) * (1.0f / D) + EPS);
        const float* mod = MOD + (size_t)(l * 5 + mod_vec_of_row(r)) * 12288 + (which ? 6144 : 0);
#pragma unroll
        for (int j = 0; j < 8; ++j) { const int c = 4 * (64 * j + lane);
            const f32x4 gv = *(const f32x4*)(gvec + c), sh = *(const f32x4*)(mod + c), scl = *(const f32x4*)(mod + 2048 + c);
            const f32x4 y = (v[j] * rstd) * gv * (1.0f + scl) + sh;
            u32x2 o; o.x = pk2(y.x, y.y); o.y = pk2(y.z, y.w);
            *(u32x2*)(H + (size_t)r * D + c) = o;
            if (first) *(f32x4*)(X + (size_t)r * D + c) = v[j]; }
    }
}
__device__ __forceinline__ void phase_final_norm(KArgs& a) {
    const int tid = otid(), lane = tid & 63, wave = tid >> 6, gw = blockIdx.x * 8 + wave, NGW = gridDim.x * 8;
    const float* X = (const float*)(a.ws + WS_X);
    for (int r = gw; r < NTOK; r += NGW) {
        const float* src = X + (size_t)r * D; f32x4 v[8]; float ss = 0.f;
#pragma unroll
        for (int j = 0; j < 8; ++j) { v[j] = ((const f32x4*)src)[64 * j + lane]; ss += (v[j].x * v[j].x + v[j].y * v[j].y) + (v[j].z * v[j].z + v[j].w * v[j].w); }
        const float rstd = rsqrtf(wave_sum(ss) * (1.0f / D) + EPS);
#pragma unroll
        for (int j = 0; j < 8; ++j) { const int c = 4 * (64 * j + lane); const f32x4 gv = *(const f32x4*)(a.in[26] + c);
            *(f32x4*)(a.out + OUT_Y + (size_t)r * D + c) = (v[j] * rstd) * gv; }
    }
}

enum { M_ID = 0, M_SILU = 1, M_GELU = 2, M_SIG = 3, M_FG = 4 };
__device__ __forceinline__ float gelu_as(float v) {
    const float av = fabsf(v), t = __builtin_amdgcn_rcpf(fmaf(av, 0.2316418882f, 1.0f));
    float q = fmaf(t, 0.5307027145f, -0.7265760135f); q = fmaf(q, t, 0.7107068705f); q = fmaf(q, t, -0.142248368f); q = fmaf(q, t, 0.127414796f); q = q * t;
    const float e = __builtin_amdgcn_exp2f(v * v * (-0.72134752044f));
    const float mm = v * (q * e);
    return v < 0.f ? mm : v - mm;
}
__device__ __forceinline__ f32x4 act4(f32x4 x, int mode, f32x4 lb) {
    f32x4 r = x;
    if (mode == M_SILU) { r.x = siluf_(x.x); r.y = siluf_(x.y); r.z = siluf_(x.z); r.w = siluf_(x.w); }
    else if (mode == M_GELU) { r.x = gelu_as(x.x); r.y = gelu_as(x.y); r.z = gelu_as(x.z); r.w = gelu_as(x.w); }
    else if (mode == M_SIG) { r.x = sigmoidf_(x.x); r.y = sigmoidf_(x.y); r.z = sigmoidf_(x.z); r.w = sigmoidf_(x.w); }
    else if (mode == M_FG) { r.x = sigmoidf_(x.x); r.y = sigmoidf_(x.y); r.z = sigmoidf_(x.z); r.w = sigmoidf_(x.w); r = lb + (1.0f - lb) * r; }
    return r;
}
struct EpiIn {
    static constexpr bool PERM = true, AFTER_DRAIN = false;
    unsigned char* ws; const float* hg_lb; const float* A_log; const float* dt_bias; int layer;
    __device__ __forceinline__ void operator()(const f32x4 (&acc)[2][2][4][2], const pg8::Unit& u, int wr, int wc, int fr, int fq) const {
        const int pn = u.pn;
        const float* hg_lb = this->hg_lb; const float* A_log = this->A_log; const float* dt_bias = this->dt_bias; unsigned char* ws = this->ws;
        asm volatile("" : "+s"(hg_lb), "+s"(A_log), "+s"(dt_bias), "+s"(ws));
        if (pn == 68) {
            if (wc != 0) return;
            float* GAB = (float*)(ws + WS_GAB);
#pragma unroll
            for (int n = 0; n < 2; ++n) {
                f32x4 al = (f32x4){0.f, 0.f, 0.f, 0.f}, db = al;
                if (fq < 2) { const f32x4 A = *(const f32x4*)(A_log + (layer * 2 + fq) * 8 + 4 * n); db = *(const f32x4*)(dt_bias + (layer * 2 + fq) * 8 + 4 * n);
                    al.x = -__expf(A.x); al.y = -__expf(A.y); al.z = -__expf(A.z); al.w = -__expf(A.w); }
#pragma unroll
                for (int ai = 0; ai < 2; ++ai)
#pragma unroll
                    for (int m = 0; m < 4; ++m) { const int row = u.pm * 256 + ai * 128 + wr * 64 + m * 16 + fr;
                        const f32x4 x = acc[ai][0][m][n]; f32x4 y;
                        if (fq < 2) { const f32x4 z = x + db;
                            y.x = al.x * ((z.x > 20.f) ? z.x : log1pf(__expf(z.x))); y.y = al.y * ((z.y > 20.f) ? z.y : log1pf(__expf(z.y)));
                            y.z = al.z * ((z.z > 20.f) ? z.z : log1pf(__expf(z.z))); y.w = al.w * ((z.w > 20.f) ? z.w : log1pf(__expf(z.w))); }
                        else { y.x = sigmoidf_(x.x); y.y = sigmoidf_(x.y); y.z = sigmoidf_(x.z); y.w = sigmoidf_(x.w); }
                        *(f32x4*)(GAB + (size_t)row * 32 + 8 * fq + 4 * n) = y;
                        asm volatile("" ::: "memory"); }
            }
            return;
        }
        int mode, ld, cb; size_t off; bool f32o = false; int dir = 0;
        if (pn < 4) { mode = M_SILU; off = WS_HQ; ld = 1024; cb = pn * 256; }
        else if (pn < 8) { mode = M_ID; off = WS_HI; ld = 1024; cb = (pn - 4) * 256; }
        else if (pn < 12) { mode = M_SILU; off = WS_HGO; ld = 1024; cb = (pn - 8) * 256; }
        else if (pn < 16) { mode = M_FG; off = WS_FF; ld = 1024; cb = (pn - 12) * 256; f32o = true; dir = 0; }
        else if (pn < 20) { mode = M_FG; off = WS_FB; ld = 1024; cb = (pn - 16) * 256; f32o = true; dir = 1; }
        else if (pn < 24) { mode = M_GELU; off = WS_CU; ld = 1024; cb = (pn - 20) * 256; }
        else if (pn < 28) { mode = M_GELU; off = WS_CV; ld = 1024; cb = (pn - 24) * 256; }
        else if (pn < 40) { mode = M_ID; off = WS_GQKV; ld = 3072; cb = (pn - 28) * 256; }
        else if (pn < 44) { mode = M_SILU; off = WS_GGO; ld = 1024; cb = (pn - 40) * 256; }
        else { mode = M_SIG; off = WS_GATES; ld = 6144; cb = (pn - 44) * 256; }
        unsigned char* base = ws + off;
#pragma unroll
        for (int bj = 0; bj < 2; ++bj) {
            const int col = cb + bj * 128 + wc * 32 + 8 * fq;
            f32x4 lb0 = (f32x4){0.f, 0.f, 0.f, 0.f}, lb1 = lb0;
            if (mode == M_FG && layer == 1) {
                const f32x4 a0 = *(const f32x4*)(hg_lb + dir * 1024 + col), a1 = *(const f32x4*)(hg_lb + dir * 1024 + col + 4);
                const f32x4 b0 = *(const f32x4*)(hg_lb + (2 + dir) * 1024 + col), b1 = *(const f32x4*)(hg_lb + (2 + dir) * 1024 + col + 4);
                lb0.x = sigmoidf_(b0.x - a0.x); lb0.y = sigmoidf_(b0.y - a0.y); lb0.z = sigmoidf_(b0.z - a0.z); lb0.w = sigmoidf_(b0.w - a0.w);
                lb1.x = sigmoidf_(b1.x - a1.x); lb1.y = sigmoidf_(b1.y - a1.y); lb1.z = sigmoidf_(b1.z - a1.z); lb1.w = sigmoidf_(b1.w - a1.w);
            }
#pragma unroll
            for (int ai = 0; ai < 2; ++ai)
#pragma unroll
                for (int m = 0; m < 4; ++m) { const int row = u.pm * 256 + ai * 128 + wr * 64 + m * 16 + fr;
                    const f32x4 y0 = act4(acc[ai][bj][m][0], mode, lb0), y1 = act4(acc[ai][bj][m][1], mode, lb1);
                    if (f32o) { float* dst = (float*)base + (size_t)row * ld + col; *(f32x4*)dst = y0; *(f32x4*)(dst + 4) = y1; }
                    else { bf16_t* dst = (bf16_t*)base + (size_t)row * ld + col;
                        u32x4 w; w.x = pk2(y0.x, y0.y); w.y = pk2(y0.z, y0.w); w.z = pk2(y1.x, y1.y); w.w = pk2(y1.z, y1.w); *(u32x4*)dst = w; }
                    asm volatile("" ::: "memory");
                }
        }
    }
};
struct EpiBr {
    static constexpr bool PERM = true, AFTER_DRAIN = false;
    unsigned char* ws; int br;
    __device__ __forceinline__ void operator()(const f32x4 (&acc)[2][2][4][2], const pg8::Unit& u, int wr, int wc, int fr, int fq) const {
        const bf16_t* GATES = (const bf16_t*)(ws + WS_GATES); float* T = (float*)(ws + WS_T32); bf16_t* MG = (bf16_t*)(ws + WS_MERGED);
#pragma unroll
        for (int ai = 0; ai < 2; ++ai)
#pragma unroll
            for (int m = 0; m < 4; ++m) { const int row = u.pm * 256 + ai * 128 + wr * 64 + m * 16 + fr;
#pragma unroll
                for (int bj = 0; bj < 2; ++bj) { const int col = u.pn * 256 + bj * 128 + wc * 32 + 8 * fq;
                    const u32x4 gw = *(const u32x4*)(GATES + (size_t)row * 6144 + br * 2048 + col);
                    f32x4 v0 = acc[ai][bj][m][0], v1 = acc[ai][bj][m][1];
                    v0 *= (f32x4){bf_lo(gw.x), bf_hi(gw.x), bf_lo(gw.y), bf_hi(gw.y)}; v1 *= (f32x4){bf_lo(gw.z), bf_hi(gw.z), bf_lo(gw.w), bf_hi(gw.w)};
                    float* t = T + (size_t)row * D + col;
                    if (br > 0) { v0 += *(const f32x4*)t; v1 += *(const f32x4*)(t + 4); }
                    if (br < 2) { *(f32x4*)t = v0; *(f32x4*)(t + 4) = v1; }
                    else { u32x4 w; w.x = pk2(v0[0], v0[1]); w.y = pk2(v0[2], v0[3]); w.z = pk2(v1[0], v1[1]); w.w = pk2(v1[2], v1[3]); *(u32x4*)(MG + (size_t)row * D + col) = w; }
                } }
    }
};
struct EpiRes {
    static constexpr bool PERM = true, AFTER_DRAIN = false;
    unsigned char* ws; int layer, goff;
    __device__ __forceinline__ void operator()(const f32x4 (&acc)[2][2][4][2], const pg8::Unit& u, int wr, int wc, int fr, int fq) const {
        float* X = (float*)(ws + WS_X); const float* MOD = (const float*)(ws + WS_MOD);
#pragma unroll
        for (int ai = 0; ai < 2; ++ai)
#pragma unroll
            for (int m = 0; m < 4; ++m) { const int row = u.pm * 256 + ai * 128 + wr * 64 + m * 16 + fr;
                const float* gate = MOD + (size_t)(layer * 5 + mod_vec_of_row(row)) * 12288 + goff;
#pragma unroll
                for (int bj = 0; bj < 2; ++bj) { const int col = u.pn * 256 + bj * 128 + wc * 32 + 8 * fq;
                    float* x = X + (size_t)row * D + col;
                    const f32x4 g0 = *(const f32x4*)(gate + col), g1 = *(const f32x4*)(gate + col + 4);
                    const f32x4 x0 = *(const f32x4*)x, x1 = *(const f32x4*)(x + 4);
                    *(f32x4*)x = x0 + g0 * acc[ai][bj][m][0]; *(f32x4*)(x + 4) = x1 + g1 * acc[ai][bj][m][1]; } }
    }
};
struct EpiRelu2 {
    static constexpr bool PERM = true, AFTER_DRAIN = false;
    unsigned char* ws;
    __device__ __forceinline__ void operator()(const f32x4 (&acc)[2][2][4][2], const pg8::Unit& u, int wr, int wc, int fr, int fq) const {
        bf16_t* FH = (bf16_t*)(ws + WS_FFH);
#pragma unroll
        for (int ai = 0; ai < 2; ++ai)
#pragma unroll
            for (int m = 0; m < 4; ++m) { const int row = u.pm * 256 + ai * 128 + wr * 64 + m * 16 + fr;
#pragma unroll
                for (int bj = 0; bj < 2; ++bj) { const int col = u.pn * 256 + bj * 128 + wc * 32 + 8 * fq;
                    f32x4 v0 = acc[ai][bj][m][0], v1 = acc[ai][bj][m][1];
                    v0 = __builtin_elementwise_max(v0, (f32x4){0.f, 0.f, 0.f, 0.f}); v1 = __builtin_elementwise_max(v1, (f32x4){0.f, 0.f, 0.f, 0.f}); v0 *= v0; v1 *= v1;
                    u32x4 w; w.x = pk2(v0[0], v0[1]); w.y = pk2(v0[2], v0[3]); w.z = pk2(v1[0], v1[1]); w.w = pk2(v1[2], v1[3]);
                    *(u32x4*)(FH + (size_t)row * DFF + col) = w; } }
    }
};

__device__ __forceinline__ void phase_gdn_prep(KArgs& a, int l) {
    const int tid = otid(), lane = tid & 63, wave = tid >> 6, gw = blockIdx.x * 8 + wave, NGW = gridDim.x * 8;
    const bf16_t* RAW = (const bf16_t*)(a.ws + WS_GQKV);
    const float* CW = a.in[16] + (size_t)l * 9 * 3072;
    for (int it = gw; it < NTOK * 24; it += NGW) {
        const int r = it / 24, ch = it - r * 24, c = ch * 128 + 2 * lane;
        float y0 = 0.f, y1 = 0.f;
        if (r < NCTX) {
            const int t = r & 255;
#pragma unroll
            for (int j = 0; j < 3; ++j) { const int tt = t + j - 1;
                if (tt >= 0 && tt < 256) { const unsigned w = *(const unsigned*)(RAW + (size_t)(r + j - 1) * 3072 + c); const f32x2 cw = *(const f32x2*)(CW + (3 + j) * 3072 + c);
                    y0 += cw.x * bf_lo(w); y1 += cw.y * bf_hi(w); } }
        } else {
            const int t = (r - NCTX) & 1023, gr = t >> 6, gc = t & 63;
#pragma unroll
            for (int i = 0; i < 3; ++i)
#pragma unroll
                for (int j = 0; j < 3; ++j) { const int rr = gr + i - 1, cc = gc + j - 1;
                    if (rr >= 0 && rr < 16 && cc >= 0 && cc < 64) { const unsigned w = *(const unsigned*)(RAW + (size_t)(r + (i - 1) * 64 + (j - 1)) * 3072 + c); const f32x2 cw = *(const f32x2*)(CW + (i * 3 + j) * 3072 + c);
                        y0 += cw.x * bf_lo(w); y1 += cw.y * bf_hi(w); } }
        }
        y0 = siluf_(y0); y1 = siluf_(y1);
        float* dst;
        if (ch < 16) { const float ss = wave_sum(y0 * y0 + y1 * y1); const float sc = rsqrtf(ss + EPS) * (ch < 8 ? 0.08838834764831845f : 1.0f); y0 *= sc; y1 *= sc;
            dst = (float*)(a.ws + (ch < 8 ? WS_GQ : WS_GK)) + (size_t)r * 1024 + (ch & 7) * 128 + 2 * lane; }
        else dst = (float*)(a.ws + WS_GV) + (size_t)r * 1024 + (ch - 16) * 128 + 2 * lane;
        *(f32x2*)dst = (f32x2){y0, y1};
    }
}

constexpr int SC_T = 32;
constexpr int SC_AOFF = 0, SC_QOFF = 20480, SC_VOFF = 40960, SC_ABOFF = 49152, SC_BUF = 49408, SC_OOFF = 2 * SC_BUF;
template <bool GDN>
__device__ __forceinline__ void scan_item(KArgs& a, LAS unsigned char* lds, int l, int s, int h, int dir, int vh) {
    const int tid = otid(), lane = tid & 63, w = tid >> 6, g = lane & 7, vl = lane >> 3;
    const int L = (s < 16) ? 256 : 1024, row0 = (s < 16) ? s * 256 : NCTX + (s - 16) * 1024, nchunk = L / SC_T;
    const int vcol = vh * 64 + w * 8 + vl;
    float S[16];
    if (s >= 16) { const float* st = a.in[GDN ? 4 : 3] + ((((size_t)(s - 16) * 2 + l) * 2 + dir) * 8 + h) * 16384;
#pragma unroll
        for (int i = 0; i < 16; ++i) S[i] = st[(16 * g + i) * 128 + vcol]; }
    else {
#pragma unroll
        for (int i = 0; i < 16; ++i) S[i] = 0.f; }
    const float* Asrc = GDN ? (const float*)(a.ws + WS_GK) : (const float*)(a.ws + (dir ? WS_FB : WS_FF));
    const float* GAB = (const float*)(a.ws + WS_GAB);
    bf16_t* OS = (bf16_t*)(a.ws + (GDN ? WS_OSG : WS_OSH)) + (size_t)dir * NTOK * 1024;
    f32x4 rA[2], rQf[2], rVf; u32x4 rQh, rVh; float rab0 = 0.f, rab1 = 0.f;
    auto issue = [&](int c) {
        const int tb = dir ? L - (c + 1) * SC_T : c * SC_T; const size_t rb = (size_t)(row0 + tb);
#pragma unroll
        for (int i = 0; i < 2; ++i) { const int idx = tid + 512 * i, rr = idx >> 5, c4 = idx & 31; rA[i] = *(const f32x4*)(Asrc + (rb + rr) * 1024 + h * 128 + 4 * c4); }
        if constexpr (GDN) {
#pragma unroll
            for (int i = 0; i < 2; ++i) { const int idx = tid + 512 * i, rr = idx >> 5, c4 = idx & 31; rQf[i] = *(const f32x4*)((const float*)(a.ws + WS_GQ) + (rb + rr) * 1024 + h * 128 + 4 * c4); }
            { const int rr = tid >> 4, c4 = tid & 15; rVf = *(const f32x4*)((const float*)(a.ws + WS_GV) + (rb + rr) * 1024 + h * 128 + vh * 64 + 4 * c4); }
            if (tid < SC_T) { rab0 = __expf(GAB[(rb + tid) * 32 + dir * 8 + h]); rab1 = GAB[(rb + tid) * 32 + 16 + dir * 8 + h]; }
        } else {
            { const int rr = tid >> 4, c8 = tid & 15; rQh = *(const u32x4*)((const bf16_t*)(a.ws + WS_HQ) + (rb + rr) * 1024 + h * 128 + 8 * c8); }
            if (tid < 256) { const int rr = tid >> 3, c8 = tid & 7; rVh = *(const u32x4*)((const bf16_t*)(a.ws + WS_HI) + (rb + rr) * 1024 + h * 128 + vh * 64 + 8 * c8); }
        }
    };
    auto commit = [&](int buf) {
        LAS float* Ab = (LAS float*)(lds + buf * SC_BUF + SC_AOFF); LAS float* Qb = (LAS float*)(lds + buf * SC_BUF + SC_QOFF);
        LAS float* Vb = (LAS float*)(lds + buf * SC_BUF + SC_VOFF); LAS float* ABb = (LAS float*)(lds + buf * SC_BUF + SC_ABOFF);
#pragma unroll
        for (int i = 0; i < 2; ++i) { const int idx = tid + 512 * i, rr = idx >> 5, d0 = 4 * (idx & 31); *(LAS f32x4*)(Ab + rr * 160 + (d0 >> 4) * 20 + (d0 & 15)) = rA[i]; }
        if constexpr (GDN) {
#pragma unroll
            for (int i = 0; i < 2; ++i) { const int idx = tid + 512 * i, rr = idx >> 5, d0 = 4 * (idx & 31); *(LAS f32x4*)(Qb + rr * 160 + (d0 >> 4) * 20 + (d0 & 15)) = rQf[i]; }
            { const int rr = tid >> 4, c4 = tid & 15; *(LAS f32x4*)(Vb + rr * 64 + 4 * c4) = rVf; }
            if (tid < SC_T) { ABb[2 * tid] = rab0; ABb[2 * tid + 1] = rab1; }
        } else {
            { const int rr = tid >> 4, d0 = 8 * (tid & 15); LAS float* q = Qb + rr * 160 + (d0 >> 4) * 20 + (d0 & 15);
              *(LAS f32x4*)q = (f32x4){bf_lo(rQh.x), bf_hi(rQh.x), bf_lo(rQh.y), bf_hi(rQh.y)}; *(LAS f32x4*)(q + 4) = (f32x4){bf_lo(rQh.z), bf_hi(rQh.z), bf_lo(rQh.w), bf_hi(rQh.w)}; }
            if (tid < 256) { const int rr = tid >> 3, j0 = 8 * (tid & 7); LAS float* v = Vb + rr * 64 + j0;
              *(LAS f32x4*)v = (f32x4){bf_lo(rVh.x), bf_hi(rVh.x), bf_lo(rVh.y), bf_hi(rVh.y)}; *(LAS f32x4*)(v + 4) = (f32x4){bf_lo(rVh.z), bf_hi(rVh.z), bf_lo(rVh.w), bf_hi(rVh.w)}; }
        }
    };
    LAS float* Ob = (LAS float*)(lds + SC_OOFF);
    issue(0); commit(0);
    __syncthreads();
    for (int c = 0; c < nchunk; ++c) {
        const int buf = c & 1;
        if (c + 1 < nchunk) issue(c + 1);
        const LAS float* Ab = (const LAS float*)(lds + buf * SC_BUF + SC_AOFF) + g * 20; const LAS float* Qb = (const LAS float*)(lds + buf * SC_BUF + SC_QOFF) + g * 20;
        const LAS float* Vb = (const LAS float*)(lds + buf * SC_BUF + SC_VOFF) + w * 8 + vl; const LAS float* ABb = (const LAS float*)(lds + buf * SC_BUF + SC_ABOFF);
#pragma unroll 2
        for (int j = 0; j < SC_T; ++j) {
            const int ii = dir ? SC_T - 1 - j : j;
            float av[16], qv[16];
#pragma unroll
            for (int i4 = 0; i4 < 4; ++i4) { const f32x4 x = *(const LAS f32x4*)(Ab + ii * 160 + 4 * i4); av[4 * i4] = x.x; av[4 * i4 + 1] = x.y; av[4 * i4 + 2] = x.z; av[4 * i4 + 3] = x.w;
                const f32x4 y = *(const LAS f32x4*)(Qb + ii * 160 + 4 * i4); qv[4 * i4] = y.x; qv[4 * i4 + 1] = y.y; qv[4 * i4 + 2] = y.z; qv[4 * i4 + 3] = y.w; }
            const float vv = Vb[ii * 64];
            float o0 = 0.f, o1 = 0.f;
            if constexpr (GDN) {
                const float al = ABb[2 * ii], be = ABb[2 * ii + 1];
                float k0 = 0.f, k1 = 0.f;
#pragma unroll
                for (int i = 0; i < 16; i += 2) { k0 = fmaf(av[i], S[i], k0); k1 = fmaf(av[i + 1], S[i + 1], k1); }
                const float ks = red8(k0 + k1);
                const float dl = be * (vv - al * ks);
#pragma unroll
                for (int i = 0; i < 16; i += 2) { S[i] = fmaf(av[i], dl, al * S[i]); S[i + 1] = fmaf(av[i + 1], dl, al * S[i + 1]); o0 = fmaf(qv[i], S[i], o0); o1 = fmaf(qv[i + 1], S[i + 1], o1); }
            } else {
#pragma unroll
                for (int i = 0; i < 16; i += 2) { S[i] = fmaf(av[i], S[i] - vv, vv); S[i + 1] = fmaf(av[i + 1], S[i + 1] - vv, vv); o0 = fmaf(qv[i], S[i], o0); o1 = fmaf(qv[i + 1], S[i + 1], o1); }
            }
            const float o = red8(o0 + o1);
            if (g == 0) Ob[ii * 64 + w * 8 + vl] = o;
        }
        __syncthreads();
        { const int tb = dir ? L - (c + 1) * SC_T : c * SC_T; const int rr = tid >> 4, j0 = 4 * (tid & 15);
          const f32x4 ov = *(const LAS f32x4*)(Ob + rr * 64 + j0); u32x2 pk; pk.x = pk2(ov.x, ov.y); pk.y = pk2(ov.z, ov.w);
          *(u32x2*)(OS + (size_t)(row0 + tb + rr) * 1024 + h * 128 + vh * 64 + j0) = pk; }
        if (c + 1 < nchunk) commit(buf ^ 1);
        __syncthreads();
    }
    if (s < 16) { float* so = a.out + (GDN ? OUT_SGDN : OUT_SHG) + ((((size_t)s * 2 + l) * 2 + dir) * 8 + h) * 16384;
#pragma unroll
        for (int i = 0; i < 16; ++i) so[(16 * g + i) * 128 + vcol] = S[i]; }
}

__device__ __forceinline__ void gmlp_item(KArgs& a, LAS unsigned char* lds, int l, int chunk, int g) {
    const int tid = otid(), lane = tid & 63, w = tid >> 6, row0 = chunk * 128;
    LAS bf16_t* vT = (LAS bf16_t*)lds;
    { const int q = tid >> 2, part = tid & 3;
      const bf16_t* src = (const bf16_t*)(a.ws + WS_CV) + (size_t)(row0 + q) * 1024 + g * 128 + part * 32;
      float x[32]; float ss = 0.f;
#pragma unroll
      for (int i = 0; i < 4; ++i) { const u32x4 r = ((const u32x4*)src)[i];
          x[8 * i] = bf_lo(r.x); x[8 * i + 1] = bf_hi(r.x); x[8 * i + 2] = bf_lo(r.y); x[8 * i + 3] = bf_hi(r.y); x[8 * i + 4] = bf_lo(r.z); x[8 * i + 5] = bf_hi(r.z); x[8 * i + 6] = bf_lo(r.w); x[8 * i + 7] = bf_hi(r.w); }
#pragma unroll
      for (int i = 0; i < 32; ++i) ss += x[i] * x[i];
      ss += __shfl_xor(ss, 1); ss += __shfl_xor(ss, 2);
      const float rstd = rsqrtf(ss * (1.0f / 128.0f) + EPS);
      const float* gn = a.in[13] + l * 1024 + g * 128 + part * 32;
#pragma unroll
      for (int i = 0; i < 32; ++i) vT[(part * 32 + i) * 136 + q] = (bf16_t)f2bf(x[i] * rstd * gn[i]);
    }
    __syncthreads();
    const int fr = lane & 15, fq = lane >> 4, p = 16 * w + fr;
    const float* wsrow = a.in[14] + (((size_t)l * 8 + g) * 128 + p) * 128;
    bf16x8 bw[4];
#pragma unroll
    for (int ks = 0; ks < 4; ++ks) { const f32x4 x0 = *(const f32x4*)(wsrow + ks * 32 + 8 * fq), x1 = *(const f32x4*)(wsrow + ks * 32 + 8 * fq + 4);
        u32x4 t; t.x = pk2(x0.x, x0.y); t.y = pk2(x0.z, x0.w); t.z = pk2(x1.x, x1.y); t.w = pk2(x1.z, x1.w); bw[ks] = __builtin_bit_cast(bf16x8, t); }
    const float bias = a.in[15][((size_t)l * 8 + g) * 128 + p];
    const bf16_t* CU = (const bf16_t*)(a.ws + WS_CU); bf16_t* OB = (bf16_t*)(a.ws + WS_OB);
#pragma unroll
    for (int ct = 0; ct < 8; ++ct) {
        f32x4 acc = (f32x4){0.f, 0.f, 0.f, 0.f};
#pragma unroll
        for (int ks = 0; ks < 4; ++ks) { const bf16x8 av = *(const LAS bf16x8*)(vT + (ct * 16 + fr) * 136 + ks * 32 + 8 * fq);
            acc = __builtin_amdgcn_mfma_f32_16x16x32_bf16(av, bw[ks], acc, 0, 0, 0); }
        const size_t o = (size_t)(row0 + p) * 1024 + g * 128 + ct * 16 + 4 * fq;
        const u32x2 uu = *(const u32x2*)(CU + o);
        u32x2 r; r.x = pk2(bf_lo(uu.x) * (acc[0] + bias), bf_hi(uu.x) * (acc[1] + bias)); r.y = pk2(bf_lo(uu.y) * (acc[2] + bias), bf_hi(uu.y) * (acc[3] + bias));
        *(u32x2*)(OB + o) = r;
    }
    __syncthreads();
}

__device__ __forceinline__ void phase_mixers(KArgs& a, LAS unsigned char* lds, int l) {
    unsigned* head = (unsigned*)(a.ws + WS_CTL) + CW_QUEUE + 64 * l;
    volatile LAS unsigned* slot = (volatile LAS unsigned*)(lds + LDS_MISC);
    for (;;) {
        if (otid() == 0) slot[0] = __hip_atomic_fetch_add(head, 1u, __ATOMIC_RELAXED, __HIP_MEMORY_SCOPE_AGENT);
        __syncthreads();
        const int idx = (int)slot[0];
        __syncthreads();
        if (idx >= 1792) break;
        if (idx < 1280) {
            int j, s; bool gdn;
            if (idx < 128) { gdn = true; j = idx; s = 16 + (j >> 5); }
            else if (idx < 256) { gdn = false; j = idx - 128; s = 16 + (j >> 5); }
            else if (idx < 768) { gdn = true; j = idx - 256; s = j >> 5; }
            else { gdn = false; j = idx - 768; s = j >> 5; }
            const int rem = j & 31, h = rem >> 2, dir = (rem >> 1) & 1, vh = rem & 1;
            if (gdn) scan_item<true>(a, lds, l, s, h, dir, vh); else scan_item<false>(a, lds, l, s, h, dir, vh);
        } else { const int j = idx - 1280; gmlp_item(a, lds, l, j >> 3, j & 7); }
    }
}

__device__ __forceinline__ void phase_onorm(KArgs& a, int l) {
    const int tid = otid(), lane = tid & 63, wave = tid >> 6, gw = blockIdx.x * 8 + wave, NGW = gridDim.x * 8;
    for (int it = gw; it < NTOK * 16; it += NGW) {
        const int br = it & 1, rh = it >> 1, r = rh >> 3, h = rh & 7;
        const bf16_t* OS = (const bf16_t*)(a.ws + (br ? WS_OSG : WS_OSH)); const size_t o = (size_t)r * 1024 + h * 128 + 2 * lane;
        const unsigned w0 = *(const unsigned*)(OS + o), w1 = *(const unsigned*)(OS + (size_t)NTOK * 1024 + o);
        float y0 = bf_lo(w0) + bf_lo(w1), y1 = bf_hi(w0) + bf_hi(w1);
        const float rstd = rsqrtf(wave_sum(y0 * y0 + y1 * y1) * (1.0f / 128.0f) + EPS);
        const f32x2 gn = *(const f32x2*)(a.in[br ? 19 : 12] + l * 128 + 2 * lane);
        const unsigned gg = *(const unsigned*)((const bf16_t*)(a.ws + (br ? WS_GGO : WS_HGO)) + o);
        y0 = y0 * rstd * gn.x * bf_lo(gg); y1 = y1 * rstd * gn.y * bf_hi(gg);
        *(unsigned*)((bf16_t*)(a.ws + (br ? WS_OC : WS_OA)) + o) = pk2(y0, y1);
    }
}

__device__ __forceinline__ void run_phase(LAS unsigned char* lds, int ph) {
    KArgs& a = *get_args();
#ifndef DIAG_ONLY
    if (ph == 0) { phase_prologue(a, lds); return; }
    if (ph == 21) { phase_final_norm(a); return; }
#else
    if (ph == 0 || ph == 21) { if (DIAG_ONLY == 10) phase_prologue(a, lds); return; }
#endif
    const int l = (ph - 1) / 10, k = (ph - 1) % 10;
    unsigned char* wl = a.ws + WS_W + (size_t)l * W_LSTRIDE;
    const int G = gridDim.x, c = blockIdx.x;
#ifdef DIAG_ONLY
    if (k != DIAG_ONLY) return;
#endif
    switch (k) {
    case 0: phase_norm_mod(a, l, 0); break;
    case 1: { pg8::Gemm g{(const bf16_t*)(a.ws + WS_H), (const bf16_t*)(wl + W_IN), NTOK, IN_PAD, D}; pg8::StaticOrder S; S.init(NTOK, IN_PAD, G, c);
              EpiIn E{a.ws, a.in[11], a.in[17], a.in[18], l}; pg8::gemm_phase<EpiIn, pg8::StaticOrder, true, true>(lds, g, S, E); } break;
    case 2: phase_gdn_prep(a, l); break;
    case 3: phase_mixers(a, lds, l); break;
    case 4: phase_onorm(a, l); break;
    case 5: {
#pragma unroll 1
        for (int br = 0; br < 3; ++br) {
            const size_t aoff = (br == 0) ? WS_OA : (br == 1 ? WS_OB : WS_OC);
            pg8::Gemm g{(const bf16_t*)(a.ws + aoff), (const bf16_t*)(wl + W_BR + (size_t)br * 4 * MiB), NTOK, D, 1024}; pg8::StaticOrder S; S.init(NTOK, D, G, c);
            EpiBr E{a.ws, br}; pg8::gemm_phase<EpiBr, pg8::StaticOrder, true, true>(lds, g, S, E); } } break;
    case 6: { pg8::Gemm g{(const bf16_t*)(a.ws + WS_MERGED), (const bf16_t*)(wl + W_OUT), NTOK, D, D}; pg8::StaticOrder S; S.init(NTOK, D, G, c);
              EpiRes E{a.ws, l, 4096}; pg8::gemm_phase<EpiRes, pg8::StaticOrder, true, true>(lds, g, S, E); } break;
    case 7: phase_norm_mod(a, l, 1); break;
    case 8: { pg8::Gemm g{(const bf16_t*)(a.ws + WS_H), (const bf16_t*)(wl + W_FF1), NTOK, DFF, D}; pg8::StaticOrder S; S.init(NTOK, DFF, G, c);
              EpiRelu2 E{a.ws}; pg8::gemm_phase<EpiRelu2, pg8::StaticOrder, true, true>(lds, g, S, E); } break;
    case 9: { pg8::Gemm g{(const bf16_t*)(a.ws + WS_FFH), (const bf16_t*)(wl + W_FF2), NTOK, D, DFF}; pg8::StaticOrder S; S.init(NTOK, D, G, c);
              EpiRes E{a.ws, l, 10240}; pg8::gemm_phase<EpiRes, pg8::StaticOrder, true, true>(lds, g, S, E); } break;
    }
}

__global__ void __launch_bounds__(NTHR, 2) fwd_megakernel(Args args) {
    extern __shared__ __attribute__((aligned(16))) unsigned char lds_raw[];
    LAS unsigned char* lds = (LAS unsigned char*)lds_raw;
#if MK_MULTI
    for (int ph = args.ph_lo; ph < args.ph_hi; ++ph) { run_phase(lds, ph); __syncthreads(); }
#else
    cg::grid_group grid = cg::this_grid();
#pragma unroll 1
    for (int ph = args.ph_lo; ph < args.ph_hi; ++ph) {
        run_phase(lds, ph);
        if (ph + 1 < args.ph_hi) { __threadfence(); grid.sync(); }
    }
#endif
}

extern "C" void kernel_launch(void* const* d_in, const int* in_sizes, int n_in, void* d_out, int out_size, void* d_ws, size_t ws_size, hipStream_t stream) {
    static int grid = 0;
    if (grid == 0) {
        int dev = 0, cus = 0, per_cu = 0;
        if (n_in != 27 || ws_size < WS_END) { fprintf(stderr, "kernel_launch: unexpected n_in %d or ws_size %zu (< %zu)\n", n_in, ws_size, (size_t)WS_END); grid = -1; return; }
        if (hipGetDevice(&dev) != hipSuccess || hipDeviceGetAttribute(&cus, hipDeviceAttributeMultiprocessorCount, dev) != hipSuccess) { grid = -1; return; }
        if (hipFuncSetAttribute((const void*)fwd_megakernel, hipFuncAttributeMaxDynamicSharedMemorySize, LDS_BYTES) != hipSuccess) { fprintf(stderr, "kernel_launch: hipFuncSetAttribute failed\n"); grid = -1; return; }
        if (hipOccupancyMaxActiveBlocksPerMultiprocessor(&per_cu, (const void*)fwd_megakernel, NTHR, LDS_BYTES) != hipSuccess || per_cu < 1) { fprintf(stderr, "kernel_launch: occupancy query failed (%d)\n", per_cu); (void)hipGetLastError(); per_cu = 1; }
        grid = cus * per_cu;
    }
    if (grid < 0) return;
    (void)hipMemsetAsync((char*)d_ws + WS_CTL, 0, CTL_BYTES, stream);
    Args a{};
    for (int i = 0; i < 27; ++i) a.in[i] = (const float*)d_in[i];
    a.out = (float*)d_out; a.ws = (unsigned char*)d_ws;
#if MK_MULTI
    for (int ph = 0; ph < N_PHASES; ++ph) { a.ph_lo = ph; a.ph_hi = ph + 1; hipLaunchKernelGGL(fwd_megakernel, dim3(grid), dim3(NTHR), LDS_BYTES, stream, a); }
#else
    a.ph_lo = 0; a.ph_hi = N_PHASES;
    void* kargs[] = {(void*)&a};
    hipError_t e = hipLaunchCooperativeKernel((const void*)fwd_megakernel, dim3(grid), dim3(NTHR), kargs, LDS_BYTES, stream);
    if (e != hipSuccess) fprintf(stderr, "kernel_launch: cooperative launch failed: %s (grid %d)\n", hipGetErrorString(e), grid);
#endif
}
```

```cpp
#include <hip/hip_runtime.h>
#include <hip/hip_cooperative_groups.h>
#include <cstdio>
#include <cstdint>
namespace cg = cooperative_groups;
namespace pg8 {
#define PG8_LAS __attribute__((address_space(3)))
typedef unsigned short bf16_t;
typedef short bf16x8 __attribute__((ext_vector_type(8)));
typedef float f32x4 __attribute__((ext_vector_type(4)));
typedef unsigned u32x4 __attribute__((ext_vector_type(4)));
constexpr int BM = 256, BK = 64, HALF = 128, HTB = HALF * BK * 2  , STAGE_BYTES = 8 * HTB, NXCD = 8, WGM = 8;

__host__ __device__ __forceinline__ int lds_byte(int r, int c) { const int st = (r >> 4) * 2 + (c >> 5), rr = r & 15, cc = c & 31, ob = rr * 64 + cc * 2; return st * 1024 + (ob ^ (((ob >> 9) & 1) << 5)); }
__host__ __device__ __forceinline__ void stage_rc(int b, int& R, int& C) { const int st = b / 1024, sb = b % 1024, swz = sb ^ (((sb >> 9) & 1) << 5); R = (st >> 1) * 16 + swz / 64; C = (st & 1) * 32 + (swz % 64) / 2; }
__host__ __device__ __forceinline__ int perm32(int rho) { const int n = rho >> 4, i = rho & 15; return 8 * (i >> 2) + 4 * n + (i & 3); }

struct Unit { int pm, pn; };
struct Gemm { const bf16_t* A; const bf16_t* Bt; int M, N, K; };

struct StaticOrder {
    int nM, nN, nwg, G, c;
    __host__ __device__ void init(int M, int N, int G_, int c_) { nM = M / BM; nN = N / BM; nwg = nM * nN; G = G_; c = c_; }
    __host__ __device__ bool next(int i, Unit& u) const {
        const long L = (long)i * G + c; if (L >= nwg) return false;
        int wgid = (int)L; { const int q = nwg / NXCD, r = nwg % NXCD, xcd = wgid % NXCD, off = wgid / NXCD; wgid = (xcd < r ? xcd * (q + 1) : r * (q + 1) + (xcd - r) * q) + off; }
        const int nig = WGM * nN, gid = wgid / nig, fm = gid * WGM, gsz = (nM - fm) < WGM ? (nM - fm) : WGM;
        u.pm = fm + ((wgid % nig) % gsz); u.pn = (wgid % nig) / gsz; return true;
    }
    __device__ __forceinline__ void a_ready(const Unit&) const {}
    __device__ __forceinline__ void done(const Unit&) const {}
};

__device__ __forceinline__ unsigned cvt_pk_bf16(float lo, float hi) { unsigned r; asm volatile("v_cvt_pk_bf16_f32 %0, %1, %2" : "=v"(r) : "v"(lo), "v"(hi)); return r; }
template <class Epi, class Sched, bool ALIGN_EPI = false, bool SP2 = false>
__device__ __forceinline__ void gemm_phase(PG8_LAS unsigned char* lds, const Gemm g, const Sched& S, const Epi& E) {
    int tid_o = threadIdx.x; asm volatile("" : "+v"(tid_o)); const int tid = tid_o, wid = __builtin_amdgcn_readfirstlane(tid >> 6), lane = tid & 63, wr = wid >> 2, wc = wid & 3, fr = lane & 15, fq = lane >> 4;
    const int K = g.K, nt = K / BK;
    unsigned voffA[2], voffB[2];
#pragma unroll
    for (int i = 0; i < 2; ++i) { int R, C; stage_rc(tid * 16 + i * 8192, R, C); const int Rb = Epi::PERM ? ((R & ~31) + perm32(R & 31)) : R;
        voffA[i] = (unsigned)(R * K + C) * 2u; voffB[i] = (unsigned)(Rb * K + C) * 2u; }
    const size_t kstep = (size_t)(BK * 2);
    const size_t hstep = (size_t)HALF * K * 2;
    const size_t tstep = 2 * hstep;
    const unsigned ldsw = (unsigned)wid * 1024u;
    const int aoff = lds_byte(wr * 64 + fr, fq * 8), boff = lds_byte(wc * 32 + fr, fq * 8);
#define PG8_SA(b, h) (((b) * 2 + (h)) * HTB)
#define PG8_SB(b, h) ((4 + (b) * 2 + (h)) * HTB)
#define PG8_STAGE(bufoff, gbase, voff) do { _Pragma("unroll") for (int _i = 0; _i < 2; ++_i) \
        __builtin_amdgcn_global_load_lds((const unsigned*)((const char*)(gbase) + (voff)[_i]), (PG8_LAS unsigned*)(lds + (bufoff) + ldsw + _i * 8192), 16, 0, 0); } while (0)
#define PG8_LDA(dst, b, h) do { _Pragma("unroll") for (int m = 0; m < 4; ++m) _Pragma("unroll") for (int k = 0; k < 2; ++k) dst[m][k] = *(const PG8_LAS bf16x8*)(lds + PG8_SA(b, h) + aoff + m * 2048 + k * 1024); } while (0)
#define PG8_LDB(dst, b, h) do { _Pragma("unroll") for (int n = 0; n < 2; ++n) _Pragma("unroll") for (int k = 0; k < 2; ++k) dst[n][k] = *(const PG8_LAS bf16x8*)(lds + PG8_SB(b, h) + boff + n * 2048 + k * 1024); } while (0)
#define PG8_MMA(ai, bj, At, Bt) do { __builtin_amdgcn_s_setprio(1); _Pragma("unroll") for (int m = 0; m < 4; ++m) _Pragma("unroll") for (int n = 0; n < 2; ++n) _Pragma("unroll") for (int k = 0; k < 2; ++k) \
        acc[ai][bj][m][n] = __builtin_amdgcn_mfma_f32_16x16x32_bf16(Bt[n][k], At[m][k], acc[ai][bj][m][n], 0, 0, 0); __builtin_amdgcn_s_setprio(0); } while (0)
#define PG8_WAIT_V(n) asm volatile("s_waitcnt vmcnt(" #n ")" ::: "memory")
#define PG8_WAIT_L(n) asm volatile("s_waitcnt lgkmcnt(" #n ")" ::: "memory")
#define PG8_BAR __builtin_amdgcn_s_barrier()
#define PG8_SCHED __builtin_amdgcn_sched_barrier(0)
    Unit cur, nxt; int ui = 0;
    if (!S.next(0, cur)) return;
    f32x4 acc[2][2][4][2];
#pragma unroll
    for (int a = 0; a < 2; ++a)
#pragma unroll
        for (int b = 0; b < 2; ++b)
#pragma unroll
            for (int m = 0; m < 4; ++m)
#pragma unroll
                for (int n = 0; n < 2; ++n) acc[a][b][m][n] = (f32x4){0.f, 0.f, 0.f, 0.f};
    bf16x8 At[4][2], B0[2][2], B1[2][2];
    const char* cA = (const char*)g.A + (size_t)cur.pm * tstep; const char* cB = (const char*)g.Bt + (size_t)cur.pn * tstep;
    S.a_ready(cur);
    if constexpr (SP2) {
        PG8_STAGE(PG8_SB(0, 0), cB, voffB); PG8_STAGE(PG8_SB(0, 1), cB + hstep, voffB); PG8_STAGE(PG8_SA(0, 0), cA, voffA); PG8_STAGE(PG8_SA(0, 1), cA + hstep, voffA);
        if (wr == 1) PG8_BAR;
        PG8_WAIT_V(2); PG8_BAR;
        PG8_STAGE(PG8_SB(1, 0), cB + kstep, voffB); PG8_STAGE(PG8_SA(1, 0), cA + kstep, voffA); PG8_STAGE(PG8_SB(1, 1), cB + hstep + kstep, voffB);
        PG8_WAIT_V(6); PG8_BAR;
    } else {
        PG8_STAGE(PG8_SB(0, 0), cB, voffB); PG8_STAGE(PG8_SA(0, 0), cA, voffA); PG8_STAGE(PG8_SB(0, 1), cB + hstep, voffB); PG8_STAGE(PG8_SA(0, 1), cA + hstep, voffA);
        if (wr == 1) PG8_BAR;
        PG8_WAIT_V(4); PG8_BAR;
        PG8_STAGE(PG8_SB(1, 0), cB + kstep, voffB); PG8_STAGE(PG8_SA(1, 0), cA + kstep, voffA); PG8_STAGE(PG8_SB(1, 1), cB + hstep + kstep, voffB);
        PG8_WAIT_V(6); PG8_BAR;
    }
    for (;;) {
        const bool has_next = S.next(ui + 1, nxt);
        const char* nA = has_next ? (const char*)g.A + (size_t)nxt.pm * tstep : cA; const char* nB = has_next ? (const char*)g.Bt + (size_t)nxt.pn * tstep : cB;
        for (int t = 0; t < nt; t += 2) {
            const bool last = (t == nt - 2);
            const char* a1 = cA + (size_t)(t + 1) * kstep;
            const char* a2 = last ? nA : cA + (size_t)(t + 2) * kstep; const char* b2 = last ? nB : cB + (size_t)(t + 2) * kstep;
            const char* a3 = a2 + kstep; const char* b3 = b2 + kstep;
            if (last && has_next) S.a_ready(nxt);
            if constexpr (SP2) {
            PG8_LDB(B0, 0, 0); PG8_LDB(B1, 0, 1); PG8_SCHED; PG8_LDA(At, 0, 0); PG8_STAGE(PG8_SA(1, 1), a1 + hstep, voffA);
            PG8_WAIT_V(8); PG8_WAIT_L(0); PG8_BAR; PG8_MMA(0, 0, At, B0); PG8_MMA(0, 1, At, B1); PG8_BAR; PG8_SCHED;
            PG8_LDA(At, 0, 1); PG8_STAGE(PG8_SB(0, 0), b2, voffB); PG8_STAGE(PG8_SB(0, 1), b2 + hstep, voffB); PG8_STAGE(PG8_SA(0, 0), a2, voffA);
            PG8_WAIT_V(8); PG8_WAIT_L(0); PG8_BAR; PG8_MMA(1, 0, At, B0); PG8_MMA(1, 1, At, B1); PG8_BAR; PG8_SCHED;
            PG8_LDB(B0, 1, 0); PG8_LDB(B1, 1, 1); PG8_SCHED; PG8_LDA(At, 1, 0); PG8_STAGE(PG8_SA(0, 1), a2 + hstep, voffA);
            PG8_WAIT_V(8); PG8_WAIT_L(0); PG8_BAR; PG8_MMA(0, 0, At, B0); PG8_MMA(0, 1, At, B1); PG8_BAR; PG8_SCHED;
            PG8_LDA(At, 1, 1); PG8_STAGE(PG8_SB(1, 0), b3, voffB); PG8_STAGE(PG8_SB(1, 1), b3 + hstep, voffB); PG8_STAGE(PG8_SA(1, 0), a3, voffA);
            PG8_WAIT_V(8); PG8_WAIT_L(0); PG8_BAR; PG8_MMA(1, 0, At, B0); PG8_MMA(1, 1, At, B1); PG8_BAR; PG8_SCHED;
            } else {
            PG8_LDB(B0, 0, 0); PG8_SCHED; PG8_LDA(At, 0, 0); PG8_STAGE(PG8_SA(1, 1), a1 + hstep, voffA);
            PG8_WAIT_L(8); PG8_BAR; PG8_WAIT_L(0); PG8_MMA(0, 0, At, B0); PG8_BAR; PG8_SCHED;
            PG8_LDB(B1, 0, 1); PG8_STAGE(PG8_SB(0, 0), b2, voffB);
            PG8_BAR; PG8_WAIT_L(0); PG8_MMA(0, 1, At, B1); PG8_BAR;
            PG8_LDA(At, 0, 1); PG8_STAGE(PG8_SA(0, 0), a2, voffA);
            PG8_BAR; PG8_WAIT_L(0); PG8_MMA(1, 0, At, B0); PG8_BAR; PG8_SCHED;
            PG8_STAGE(PG8_SB(0, 1), b2 + hstep, voffB);
            PG8_WAIT_V(6); PG8_BAR; PG8_MMA(1, 1, At, B1); PG8_BAR;
            PG8_LDB(B0, 1, 0); PG8_SCHED; PG8_LDA(At, 1, 0); PG8_STAGE(PG8_SA(0, 1), a2 + hstep, voffA);
            PG8_WAIT_L(8); PG8_BAR; PG8_WAIT_L(0); PG8_MMA(0, 0, At, B0); PG8_BAR; PG8_SCHED;
            PG8_LDB(B1, 1, 1); PG8_STAGE(PG8_SB(1, 0), b3, voffB);
            PG8_BAR; PG8_WAIT_L(0); PG8_MMA(0, 1, At, B1); PG8_BAR;
            PG8_LDA(At, 1, 1); PG8_STAGE(PG8_SA(1, 0), a3, voffA);
            PG8_BAR; PG8_WAIT_L(0); PG8_MMA(1, 0, At, B0); PG8_BAR; PG8_SCHED;
            PG8_STAGE(PG8_SB(1, 1), b3 + hstep, voffB);
            PG8_WAIT_V(6); PG8_BAR; PG8_MMA(1, 1, At, B1); PG8_BAR;
            }
        }
        if constexpr (ALIGN_EPI) { if (wr == 0) PG8_BAR; }
        bool keep_acc = false;
        if constexpr (!Epi::AFTER_DRAIN) { E(acc, cur, wr, wc, fr, fq); if constexpr (Epi::KEEP) keep_acc = E.keep(cur); S.done(cur); }
        if (!has_next) break;
        if (!keep_acc)
#pragma unroll
        for (int a = 0; a < 2; ++a)
#pragma unroll
            for (int b = 0; b < 2; ++b)
#pragma unroll
                for (int m = 0; m < 4; ++m)
#pragma unroll
                    for (int n = 0; n < 2; ++n) acc[a][b][m][n] = (f32x4){0.f, 0.f, 0.f, 0.f};
        cur = nxt; cA = nA; cB = nB; ++ui;
        if constexpr (ALIGN_EPI) { if (wr == 1) PG8_BAR; }
    }
    PG8_WAIT_V(0);
    if constexpr (!ALIGN_EPI) { if (wr == 0) PG8_BAR; }
    PG8_BAR;
    if constexpr (Epi::AFTER_DRAIN) { E.fused(acc, cur, wr, wc, fr, fq, lds, wid, lane); S.done(cur); }
#undef PG8_SA
#undef PG8_SB
#undef PG8_STAGE
#undef PG8_LDA
#undef PG8_LDB
#undef PG8_MMA
#undef PG8_WAIT_V
#undef PG8_WAIT_L
#undef PG8_BAR
#undef PG8_SCHED
}
}


#ifndef MK_MULTI
#define MK_MULTI 0
#endif
#define LAS __attribute__((address_space(3)))
typedef unsigned short bf16_t;
typedef float f32x4 __attribute__((ext_vector_type(4)));
typedef float f32x2 __attribute__((ext_vector_type(2)));
typedef unsigned u32x4 __attribute__((ext_vector_type(4)));
typedef unsigned u32x2 __attribute__((ext_vector_type(2)));
typedef short bf16x8 __attribute__((ext_vector_type(8)));

constexpr int D = 2048, NTOK = 8192, NCTX = 4096, IN_DIM = 17440, IN_PAD = 17664, DFF = 8192;
constexpr int NTHR = 512;
constexpr float EPS = 1e-6f;
constexpr size_t MiB = 1u << 20;
constexpr size_t WS_CTL = 0, CTL_BYTES = 1 * MiB;
constexpr size_t WS_MOD = 1 * MiB;
constexpr size_t WS_W = 2 * MiB, W_LSTRIDE = 153 * MiB;
constexpr size_t W_IN = 0, W_BR = 69 * MiB, W_OUT = 81 * MiB, W_FF1 = 89 * MiB, W_FF2 = 121 * MiB;
constexpr size_t WS_X = 308 * MiB;
constexpr size_t WS_H = 372 * MiB;
constexpr size_t WS_FF = 404 * MiB, WS_FB = 436 * MiB;
constexpr size_t WS_HQ = 468 * MiB, WS_HI = 484 * MiB, WS_HGO = 500 * MiB, WS_CU = 516 * MiB, WS_CV = 532 * MiB;
constexpr size_t WS_GQKV = 548 * MiB;
constexpr size_t WS_GGO = 596 * MiB;
constexpr size_t WS_GATES = 612 * MiB;
constexpr size_t WS_GAB = 708 * MiB;
constexpr size_t WS_GQ = 709 * MiB, WS_GK = 741 * MiB, WS_GV = 773 * MiB;
constexpr size_t WS_OA = 805 * MiB, WS_OB = 821 * MiB, WS_OC = 837 * MiB;
constexpr size_t WS_END = 853 * MiB;
constexpr size_t WS_OSH = WS_H;
constexpr size_t WS_OSG = WS_GQKV;
constexpr size_t WS_FFH = WS_FF;
constexpr size_t WS_MERGED = WS_GV;
constexpr int CW_QUEUE = 64;
constexpr int CW_BAR = 4096;
constexpr int LDS_MISC = 132096, LDS_BYTES = 132096 + 512;
constexpr size_t OUT_Y = 0, OUT_SHG = (size_t)NTOK * D, OUT_SGDN = OUT_SHG + (size_t)16 * 2 * 2 * 8 * 16384;
constexpr int N_PHASES = 22;

__device__ __forceinline__ int otid() { int t = threadIdx.x; asm volatile("" : "+v"(t)); return t; }
__device__ __forceinline__ int obid() { int t = blockIdx.x; asm volatile("" : "+s"(t)); return t; }
struct Args { const float* in[27]; float* out; unsigned char* ws; int ph_lo, ph_hi; };
typedef const Args __attribute__((address_space(4))) KArgs;
__device__ __forceinline__ KArgs* get_args() { KArgs* p = (KArgs*)__builtin_amdgcn_kernarg_segment_ptr(); asm volatile("" : "+s"(p)); return p; }

__device__ __forceinline__ unsigned f2bf(float f) { unsigned u = __builtin_bit_cast(unsigned, f); return (u + 0x7fffu + ((u >> 16) & 1u)) >> 16; }
typedef __bf16 bf16x2_nat __attribute__((ext_vector_type(2)));
__device__ __forceinline__ unsigned pk2(float lo, float hi) { const f32x2 v = {lo, hi}; return __builtin_bit_cast(unsigned, __builtin_convertvector(v, bf16x2_nat)); }
__device__ __forceinline__ float bf_lo(unsigned w) { return __builtin_bit_cast(float, w << 16); }
__device__ __forceinline__ float bf_hi(unsigned w) { return __builtin_bit_cast(float, w & 0xffff0000u); }
__device__ __forceinline__ float wave_sum(float v) {
#pragma unroll
    for (int o = 1; o < 64; o <<= 1) v += __shfl_xor(v, o);
    return v;
}
__device__ __forceinline__ float sigmoidf_(float x) { return __builtin_amdgcn_rcpf(1.0f + __expf(-x)); }
__device__ __forceinline__ float siluf_(float x) { return x * __builtin_amdgcn_rcpf(1.0f + __expf(-x)); }
__device__ __forceinline__ float geluf_(float x) { return 0.5f * x * (1.0f + erff(x * 0.70710678118f)); }
#define LDS_BARRIER() do { asm volatile("s_waitcnt lgkmcnt(0)" ::: "memory"); __builtin_amdgcn_s_barrier(); asm volatile("" ::: "memory"); } while (0)
__device__ __forceinline__ float red16(float x) {
    int t;
    t = __builtin_amdgcn_update_dpp(0, __builtin_bit_cast(int, x), 0xB1, 0xF, 0xF, false); x += __builtin_bit_cast(float, t);
    t = __builtin_amdgcn_update_dpp(0, __builtin_bit_cast(int, x), 0x4E, 0xF, 0xF, false); x += __builtin_bit_cast(float, t);
    t = __builtin_amdgcn_update_dpp(0, __builtin_bit_cast(int, x), 0x141, 0xF, 0xF, false); x += __builtin_bit_cast(float, t);
    t = __builtin_amdgcn_update_dpp(0, __builtin_bit_cast(int, x), 0x140, 0xF, 0xF, false); x += __builtin_bit_cast(float, t);
    return x;
}
struct TItem { const float* p; bf16_t* q; int N, K; };
constexpr int TI_IN = 32 * 545, TI_BR = 16 * 64, TI_OUT = 32 * 64, TI_F1 = 32 * 256, TI_F2 = 128 * 64, TI_L = TI_IN + 3 * TI_BR + TI_OUT + TI_F1 + TI_F2;
__device__ __forceinline__ void titem_decode(KArgs& a, int it, int lane, TItem& t) {
    const int l = it / TI_L; int r = it - l * TI_L;
    unsigned char* wl = a.ws + WS_W + (size_t)l * W_LSTRIDE;
    const float* W; bf16_t* WT; int K, N; bool remap = false;
    if (r < TI_IN) { W = a.in[10] + (size_t)l * 2048 * IN_DIM; K = 2048; N = IN_DIM; WT = (bf16_t*)(wl + W_IN); remap = true; }
    else if ((r -= TI_IN) < TI_BR) { W = a.in[20] + (size_t)l * 1024 * 2048; K = 1024; N = 2048; WT = (bf16_t*)(wl + W_BR); }
    else if ((r -= TI_BR) < TI_BR) { W = a.in[21] + (size_t)l * 1024 * 2048; K = 1024; N = 2048; WT = (bf16_t*)(wl + W_BR + 4 * MiB); }
    else if ((r -= TI_BR) < TI_BR) { W = a.in[22] + (size_t)l * 1024 * 2048; K = 1024; N = 2048; WT = (bf16_t*)(wl + W_BR + 8 * MiB); }
    else if ((r -= TI_BR) < TI_OUT) { W = a.in[23] + (size_t)l * 2048 * 2048; K = 2048; N = 2048; WT = (bf16_t*)(wl + W_OUT); }
    else if ((r -= TI_OUT) < TI_F1) { W = a.in[24] + (size_t)l * 2048 * 8192; K = 2048; N = 8192; WT = (bf16_t*)(wl + W_FF1); }
    else { r -= TI_F1; W = a.in[25] + (size_t)l * 8192 * 2048; K = 8192; N = 2048; WT = (bf16_t*)(wl + W_FF2); }
    const int nblk = N / 32, kb = r / nblk, nb = r - kb * nblk, k0 = 64 * kb, n0 = 32 * nb;
    int drow0 = n0;
    if (remap) drow0 = (n0 < 11264) ? n0 : ((n0 < 11296) ? 17408 : n0 - 32);
    t.p = W + (size_t)(k0 + (lane >> 3)) * N + n0 + 4 * (lane & 7); t.N = N; t.K = K;
    t.q = WT + (size_t)(drow0 + (lane >> 3)) * K + k0 + 8 * (lane & 7);
}
__device__ __forceinline__ void titem_load(const TItem& t, f32x4 (&v)[8]) {
#pragma unroll
    for (int i = 0; i < 8; ++i) v[i] = __builtin_nontemporal_load((const f32x4*)(t.p + (size_t)(8 * i) * t.N));
}
__device__ __forceinline__ void titem_store(const TItem& t, const f32x4 (&v)[8], LAS float* scr, int lane) {
    const int kr = lane >> 3, n4 = 4 * (lane & 7);
#pragma unroll
    for (int i = 0; i < 8; ++i) { LAS float* d = scr + (kr + 8 * i) * 33 + n4; d[0] = v[i].x; d[1] = v[i].y; d[2] = v[i].z; d[3] = v[i].w; }
    asm volatile("s_waitcnt lgkmcnt(0)" ::: "memory");
    const int c = lane & 7;
#pragma unroll
    for (int j = 0; j < 4; ++j) { const int n = (lane >> 3) + 8 * j; const LAS float* s = scr + (8 * c) * 33 + n;
        u32x4 o; o.x = pk2(s[0 * 33], s[1 * 33]); o.y = pk2(s[2 * 33], s[3 * 33]); o.z = pk2(s[4 * 33], s[5 * 33]); o.w = pk2(s[6 * 33], s[7 * 33]);
        *(u32x4*)(t.q + (size_t)(8 * j) * t.K) = o; }
    asm volatile("s_waitcnt lgkmcnt(0)" ::: "memory");
}

__device__ __forceinline__ void titem_range(KArgs& a, LAS float* scr, int lane, int it0, int tot, int step) {
    TItem ta, tb; f32x4 va[8], vb[8];
    int it = it0;
    if (it < tot) { titem_decode(a, it, lane, ta); titem_load(ta, va); }
    for (;;) {
        if (it >= tot) break;
        if (it + step < tot) { titem_decode(a, it + step, lane, tb); titem_load(tb, vb); }
        titem_store(ta, va, scr, lane);
        it += step;
        if (it >= tot) break;
        if (it + step < tot) { titem_decode(a, it + step, lane, ta); titem_load(ta, va); }
        titem_store(tb, vb, scr, lane);
        it += step;
    }
}
constexpr int BG_PER = 64;
constexpr int BG0_FIRST = TI_IN, BG0_END = TI_L + TI_IN, BG0_SUPER = (BG0_END - BG0_FIRST + BG_PER - 1) / BG_PER;
constexpr int BG1_FIRST = TI_L + TI_IN, BG1_END = 2 * TI_L, BG1_SUPER = (BG1_END - BG1_FIRST + BG_PER - 1) / BG_PER;
__device__ __forceinline__ void conv_super_item(KArgs& a, LAS unsigned char* lds, int first, int last, int sidx) {
    const int tid = otid(), lane = tid & 63, wave = tid >> 6;
    const int base = first + BG_PER * sidx, end = (base + BG_PER < last) ? base + BG_PER : last;
    titem_range(a, (LAS float*)(lds + wave * 16384), lane, base + wave, end, 8);
    __syncthreads();
}

__device__ __forceinline__ void phase_prologue(KArgs& a, LAS unsigned char* lds) {
    const int tid = otid(), lane = tid & 63, wave = tid >> 6, G = gridDim.x;
    float* MOD = (float*)(a.ws + WS_MOD);
    LAS float* sc = (LAS float*)lds;
    LAS float* red = (LAS float*)(lds + 40960);
    for (int i = tid; i < 5 * 2048; i += NTHR) { const int v = i >> 11, k = i & 2047; const float x = (v == 0) ? a.in[5][k] : a.in[2][(v - 1) * 2048 + k]; sc[i] = siluf_(x); }
    __syncthreads();
    for (int chunk = blockIdx.x; chunk < 256; chunk += G) {
        const int l = chunk >> 7, n0 = (chunk & 127) * 96;
        if (tid < 384) {
            const int kg = tid / 24, ln = tid % 24;
            const float* W = a.in[8] + ((size_t)l * 2048 + kg * 128) * 12288 + n0 + 4 * ln;
            f32x4 acc[5];
#pragma unroll
            for (int v = 0; v < 5; ++v) acc[v] = (f32x4){0.f, 0.f, 0.f, 0.f};
#pragma unroll 16
            for (int k = 0; k < 128; ++k) {
                const f32x4 w = __builtin_nontemporal_load((const f32x4*)(W + (size_t)k * 12288));
#pragma unroll
                for (int v = 0; v < 5; ++v) { const float s = sc[v * 2048 + kg * 128 + k]; acc[v] += s * w; }
            }
#pragma unroll
            for (int v = 0; v < 5; ++v) *(LAS f32x4*)(red + (kg * 5 + v) * 96 + 4 * ln) = acc[v];
        }
        __syncthreads();
        if (tid < 480) { const int v = tid / 96, c = tid % 96; float s = 0.f;
#pragma unroll
            for (int kg = 0; kg < 16; ++kg) s += red[(kg * 5 + v) * 96 + c];
            MOD[(l * 5 + v) * 12288 + n0 + c] = s + a.in[9][l * 12288 + n0 + c]; }
        __syncthreads();
    }
    LAS float* scr = (LAS float*)(lds + wave * 16384);
    const int gw = blockIdx.x * 8 + wave, NGW = G * 8;
    titem_range(a, scr, lane, gw, TI_IN, NGW);
    for (int i = blockIdx.x * NTHR + tid; i < 2 * 57344; i += G * NTHR) { const int l = i / 57344, j = i - l * 57344;
        *(u32x4*)(a.ws + WS_W + (size_t)l * W_LSTRIDE + W_IN + (size_t)IN_DIM * 4096 + (size_t)j * 16) = (u32x4){0u, 0u, 0u, 0u}; }
}

__device__ __forceinline__ int mod_vec_of_row(int r) { return r < NCTX ? 0 : 1 + ((r - NCTX) >> 10); }

__device__ __forceinline__ void load_row8(const float* srcf, const bf16_t* srcb, int lane, float (&v)[4][8]) {
#pragma unroll
    for (int j = 0; j < 4; ++j) { const int c = 8 * (64 * j + lane);
        if (srcf) { const f32x4 x0 = *(const f32x4*)(srcf + c), x1 = *(const f32x4*)(srcf + c + 4);
            v[j][0] = x0.x; v[j][1] = x0.y; v[j][2] = x0.z; v[j][3] = x0.w; v[j][4] = x1.x; v[j][5] = x1.y; v[j][6] = x1.z; v[j][7] = x1.w; }
        else { const u32x4 p = *(const u32x4*)(srcb + c);
            v[j][0] = bf_lo(p.x); v[j][1] = bf_hi(p.x); v[j][2] = bf_lo(p.y); v[j][3] = bf_hi(p.y); v[j][4] = bf_lo(p.z); v[j][5] = bf_hi(p.z); v[j][6] = bf_lo(p.w); v[j][7] = bf_hi(p.w); } }
}
__device__ __forceinline__ void phase_norm_mod(KArgs& a, int l, int which) {
    const int tid = otid(), lane = tid & 63, wave = tid >> 6, gw = blockIdx.x * 8 + wave, NGW = gridDim.x * 8;
    bf16_t* X = (bf16_t*)(a.ws + WS_X); bf16_t* H = (bf16_t*)(a.ws + WS_H); const float* MOD = (const float*)(a.ws + WS_MOD);
    const bool first = (which == 0 && l == 0);
    const float* gvec = (which ? a.in[7] : a.in[6]) + l * 2048;
    for (int r0 = gw; r0 < NTOK; r0 += 2 * NGW) {
        float v[2][4][8];
#pragma unroll
        for (int u = 0; u < 2; ++u) { const int r = r0 + u * NGW;
            if (r < NTOK) load_row8(first ? (r < NCTX ? a.in[0] + (size_t)r * D : a.in[1] + (size_t)(r - NCTX) * D) : nullptr, X + (size_t)r * D, lane, v[u]); }
#pragma unroll
        for (int u = 0; u < 2; ++u) { const int r = r0 + u * NGW;
            if (r < NTOK) { float ss = 0.f;
#pragma unroll
                for (int j = 0; j < 4; ++j)
#pragma unroll
                    for (int e = 0; e < 8; ++e) ss += v[u][j][e] * v[u][j][e];
                const float rstd = rsqrtf(wave_sum(ss) * (1.0f / D) + EPS);
                const float* mod = MOD + (size_t)(l * 5 + mod_vec_of_row(r)) * 12288 + (which ? 6144 : 0);
#pragma unroll
                for (int j = 0; j < 4; ++j) { const int c = 8 * (64 * j + lane); float y[8];
#pragma unroll
                    for (int hf = 0; hf < 2; ++hf) { const f32x4 gv = *(const f32x4*)(gvec + c + 4 * hf), sh = *(const f32x4*)(mod + c + 4 * hf), scl = *(const f32x4*)(mod + 2048 + c + 4 * hf);
                        y[4 * hf] = v[u][j][4 * hf] * rstd * gv.x * (1.0f + scl.x) + sh.x; y[4 * hf + 1] = v[u][j][4 * hf + 1] * rstd * gv.y * (1.0f + scl.y) + sh.y;
                        y[4 * hf + 2] = v[u][j][4 * hf + 2] * rstd * gv.z * (1.0f + scl.z) + sh.z; y[4 * hf + 3] = v[u][j][4 * hf + 3] * rstd * gv.w * (1.0f + scl.w) + sh.w; }
                    u32x4 o; o.x = pk2(y[0], y[1]); o.y = pk2(y[2], y[3]); o.z = pk2(y[4], y[5]); o.w = pk2(y[6], y[7]);
                    *(u32x4*)(H + (size_t)r * D + c) = o;
                    if (first) { u32x4 xo; xo.x = pk2(v[u][j][0], v[u][j][1]); xo.y = pk2(v[u][j][2], v[u][j][3]); xo.z = pk2(v[u][j][4], v[u][j][5]); xo.w = pk2(v[u][j][6], v[u][j][7]); *(u32x4*)(X + (size_t)r * D + c) = xo; } } } }
    }
}
__device__ __forceinline__ void phase_final_norm(KArgs& a) {
    const int tid = otid(), lane = tid & 63, wave = tid >> 6, gw = blockIdx.x * 8 + wave, NGW = gridDim.x * 8;
    const bf16_t* X = (const bf16_t*)(a.ws + WS_X);
    for (int r = gw; r < NTOK; r += NGW) {
        float v[4][8]; load_row8(nullptr, X + (size_t)r * D, lane, v);
        float ss = 0.f;
#pragma unroll
        for (int j = 0; j < 4; ++j)
#pragma unroll
            for (int e = 0; e < 8; ++e) ss += v[j][e] * v[j][e];
        const float rstd = rsqrtf(wave_sum(ss) * (1.0f / D) + EPS);
#pragma unroll
        for (int j = 0; j < 4; ++j) { const int c = 8 * (64 * j + lane);
            const f32x4 g0 = *(const f32x4*)(a.in[26] + c), g1 = *(const f32x4*)(a.in[26] + c + 4);
            float* o = a.out + OUT_Y + (size_t)r * D + c;
            *(f32x4*)o = (f32x4){v[j][0] * rstd * g0.x, v[j][1] * rstd * g0.y, v[j][2] * rstd * g0.z, v[j][3] * rstd * g0.w};
            *(f32x4*)(o + 4) = (f32x4){v[j][4] * rstd * g1.x, v[j][5] * rstd * g1.y, v[j][6] * rstd * g1.z, v[j][7] * rstd * g1.w}; }
    }
}

enum { M_ID = 0, M_SILU = 1, M_GELU = 2, M_SIG = 3, M_FG = 4 };
__device__ __forceinline__ float gelu_as(float v) {
    const float av = fabsf(v), t = __builtin_amdgcn_rcpf(fmaf(av, 0.2316418882f, 1.0f));
    float q = fmaf(t, 0.5307027145f, -0.7265760135f); q = fmaf(q, t, 0.7107068705f); q = fmaf(q, t, -0.142248368f); q = fmaf(q, t, 0.127414796f); q = q * t;
    const float e = __builtin_amdgcn_exp2f(v * v * (-0.72134752044f));
    const float mm = v * (q * e);
    return v < 0.f ? mm : v - mm;
}
__device__ __forceinline__ f32x4 act4(f32x4 x, int mode, f32x4 lb) {
    f32x4 r = x;
    if (mode == M_SILU) { r.x = siluf_(x.x); r.y = siluf_(x.y); r.z = siluf_(x.z); r.w = siluf_(x.w); }
    else if (mode == M_GELU) { r.x = gelu_as(x.x); r.y = gelu_as(x.y); r.z = gelu_as(x.z); r.w = gelu_as(x.w); }
    else if (mode == M_SIG) { r.x = sigmoidf_(x.x); r.y = sigmoidf_(x.y); r.z = sigmoidf_(x.z); r.w = sigmoidf_(x.w); }
    else if (mode == M_FG) { r.x = sigmoidf_(x.x); r.y = sigmoidf_(x.y); r.z = sigmoidf_(x.z); r.w = sigmoidf_(x.w); r = lb + (1.0f - lb) * r; }
    return r;
}
struct EpiIn {
    static constexpr bool PERM = true, AFTER_DRAIN = false, KEEP = false;
    unsigned char* ws; const float* hg_lb; const float* A_log; const float* dt_bias; int layer;
    __device__ __forceinline__ void operator()(const f32x4 (&acc)[2][2][4][2], const pg8::Unit& u, int wr, int wc, int fr, int fq) const {
        const int pn = u.pn;
        const float* hg_lb = this->hg_lb; const float* A_log = this->A_log; const float* dt_bias = this->dt_bias; unsigned char* ws = this->ws;
        asm volatile("" : "+s"(hg_lb), "+s"(A_log), "+s"(dt_bias), "+s"(ws));
        if (pn == 68) {
            if (wc != 0) return;
            float* GAB = (float*)(ws + WS_GAB);
#pragma unroll
            for (int n = 0; n < 2; ++n) {
                f32x4 al = (f32x4){0.f, 0.f, 0.f, 0.f}, db = al;
                if (fq < 2) { const f32x4 A = *(const f32x4*)(A_log + (layer * 2 + fq) * 8 + 4 * n); db = *(const f32x4*)(dt_bias + (layer * 2 + fq) * 8 + 4 * n);
                    al.x = -__expf(A.x); al.y = -__expf(A.y); al.z = -__expf(A.z); al.w = -__expf(A.w); }
#pragma unroll
                for (int ai = 0; ai < 2; ++ai)
#pragma unroll
                    for (int m = 0; m < 4; ++m) { const int row = u.pm * 256 + ai * 128 + wr * 64 + m * 16 + fr;
                        const f32x4 x = acc[ai][0][m][n]; f32x4 y;
                        if (fq < 2) { const f32x4 z = x + db;
                            y.x = al.x * ((z.x > 20.f) ? z.x : log1pf(__expf(z.x))); y.y = al.y * ((z.y > 20.f) ? z.y : log1pf(__expf(z.y)));
                            y.z = al.z * ((z.z > 20.f) ? z.z : log1pf(__expf(z.z))); y.w = al.w * ((z.w > 20.f) ? z.w : log1pf(__expf(z.w))); }
                        else { y.x = sigmoidf_(x.x); y.y = sigmoidf_(x.y); y.z = sigmoidf_(x.z); y.w = sigmoidf_(x.w); }
                        *(f32x4*)(GAB + (size_t)row * 32 + 8 * fq + 4 * n) = y;
                        asm volatile("" ::: "memory"); }
            }
            return;
        }
        int mode, ld, cb; size_t off; bool f32o = false; int dir = 0;
        if (pn < 4) { mode = M_SILU; off = WS_HQ; ld = 1024; cb = pn * 256; }
        else if (pn < 8) { mode = M_ID; off = WS_HI; ld = 1024; cb = (pn - 4) * 256; }
        else if (pn < 12) { mode = M_SILU; off = WS_HGO; ld = 1024; cb = (pn - 8) * 256; }
        else if (pn < 16) { mode = M_FG; off = WS_FF; ld = 1024; cb = (pn - 12) * 256; f32o = true; dir = 0; }
        else if (pn < 20) { mode = M_FG; off = WS_FB; ld = 1024; cb = (pn - 16) * 256; f32o = true; dir = 1; }
        else if (pn < 24) { mode = M_GELU; off = WS_CU; ld = 1024; cb = (pn - 20) * 256; }
        else if (pn < 28) { mode = M_GELU; off = WS_CV; ld = 1024; cb = (pn - 24) * 256; }
        else if (pn < 40) { mode = M_ID; off = WS_GQKV; ld = 3072; cb = (pn - 28) * 256; }
        else if (pn < 44) { mode = M_SILU; off = WS_GGO; ld = 1024; cb = (pn - 40) * 256; }
        else { mode = M_SIG; off = WS_GATES; ld = 6144; cb = (pn - 44) * 256; }
        unsigned char* base = ws + off;
#pragma unroll
        for (int bj = 0; bj < 2; ++bj) {
            const int col = cb + bj * 128 + wc * 32 + 8 * fq;
            f32x4 lb0 = (f32x4){0.f, 0.f, 0.f, 0.f}, lb1 = lb0;
            if (mode == M_FG && layer == 1) {
                const f32x4 a0 = *(const f32x4*)(hg_lb + dir * 1024 + col), a1 = *(const f32x4*)(hg_lb + dir * 1024 + col + 4);
                const f32x4 b0 = *(const f32x4*)(hg_lb + (2 + dir) * 1024 + col), b1 = *(const f32x4*)(hg_lb + (2 + dir) * 1024 + col + 4);
                lb0.x = sigmoidf_(b0.x - a0.x); lb0.y = sigmoidf_(b0.y - a0.y); lb0.z = sigmoidf_(b0.z - a0.z); lb0.w = sigmoidf_(b0.w - a0.w);
                lb1.x = sigmoidf_(b1.x - a1.x); lb1.y = sigmoidf_(b1.y - a1.y); lb1.z = sigmoidf_(b1.z - a1.z); lb1.w = sigmoidf_(b1.w - a1.w);
            }
#pragma unroll
            for (int ai = 0; ai < 2; ++ai)
#pragma unroll
                for (int m = 0; m < 4; ++m) { const int row = u.pm * 256 + ai * 128 + wr * 64 + m * 16 + fr;
                    const f32x4 y0 = act4(acc[ai][bj][m][0], mode, lb0), y1 = act4(acc[ai][bj][m][1], mode, lb1);
                    if (f32o) { float* dst = (float*)base + (size_t)row * ld + col; *(f32x4*)dst = y0; *(f32x4*)(dst + 4) = y1; }
                    else { bf16_t* dst = (bf16_t*)base + (size_t)row * ld + col;
                        u32x4 w; w.x = pk2(y0.x, y0.y); w.y = pk2(y0.z, y0.w); w.z = pk2(y1.x, y1.y); w.w = pk2(y1.z, y1.w); *(u32x4*)dst = w; }
                    asm volatile("" ::: "memory");
                }
        }
    }
};
struct Br3Order {
    pg8::StaticOrder base;
    __device__ __forceinline__ bool next(int i, pg8::Unit& u) const { const int rd = i / 3, br = i - 3 * rd; pg8::Unit ub; if (!base.next(rd, ub)) return false; u.pm = br * 32 + ub.pm; u.pn = br * 8 + ub.pn; return true; }
    __device__ __forceinline__ void a_ready(const pg8::Unit&) const {}
    __device__ __forceinline__ void done(const pg8::Unit&) const {}
};
struct EpiBr3 {
    static constexpr bool PERM = true, AFTER_DRAIN = false, KEEP = true;
    unsigned char* ws;
    __device__ __forceinline__ bool keep(const pg8::Unit& u) const { return u.pm < 64; }
    __device__ __forceinline__ void operator()(f32x4 (&acc)[2][2][4][2], const pg8::Unit& u, int wr, int wc, int fr, int fq) const {
        const bf16_t* GATES = (const bf16_t*)(ws + WS_GATES); bf16_t* MG = (bf16_t*)(ws + WS_MERGED);
        const int br = u.pm >> 5, pm = u.pm & 31, pn = u.pn & 7;
#pragma unroll
        for (int ai = 0; ai < 2; ++ai)
#pragma unroll
            for (int m = 0; m < 4; ++m) { const int row = pm * 256 + ai * 128 + wr * 64 + m * 16 + fr;
#pragma unroll
                for (int bj = 0; bj < 2; ++bj) { const int col = pn * 256 + bj * 128 + wc * 32 + 8 * fq;
                    const bf16_t* gp = GATES + (size_t)row * 6144 + col;
                    const u32x4 gw = *(const u32x4*)(gp + br * 2048);
                    f32x4 c0 = (f32x4){bf_lo(gw.x), bf_hi(gw.x), bf_lo(gw.y), bf_hi(gw.y)}, c1 = (f32x4){bf_lo(gw.z), bf_hi(gw.z), bf_lo(gw.w), bf_hi(gw.w)};
                    if (br > 0) { c0 = __builtin_elementwise_max(c0, (f32x4){1e-6f, 1e-6f, 1e-6f, 1e-6f}); c1 = __builtin_elementwise_max(c1, (f32x4){1e-6f, 1e-6f, 1e-6f, 1e-6f}); }
                    if (br < 2) { const u32x4 gn = *(const u32x4*)(gp + (br + 1) * 2048);
                        f32x4 n0 = (f32x4){bf_lo(gn.x), bf_hi(gn.x), bf_lo(gn.y), bf_hi(gn.y)}, n1 = (f32x4){bf_lo(gn.z), bf_hi(gn.z), bf_lo(gn.w), bf_hi(gn.w)};
                        n0 = __builtin_elementwise_max(n0, (f32x4){1e-6f, 1e-6f, 1e-6f, 1e-6f}); n1 = __builtin_elementwise_max(n1, (f32x4){1e-6f, 1e-6f, 1e-6f, 1e-6f});
                        c0.x *= __builtin_amdgcn_rcpf(n0.x); c0.y *= __builtin_amdgcn_rcpf(n0.y); c0.z *= __builtin_amdgcn_rcpf(n0.z); c0.w *= __builtin_amdgcn_rcpf(n0.w);
                        c1.x *= __builtin_amdgcn_rcpf(n1.x); c1.y *= __builtin_amdgcn_rcpf(n1.y); c1.z *= __builtin_amdgcn_rcpf(n1.z); c1.w *= __builtin_amdgcn_rcpf(n1.w);
                        acc[ai][bj][m][0] *= c0; acc[ai][bj][m][1] *= c1; }
                    else { const f32x4 v0 = acc[ai][bj][m][0] * c0, v1 = acc[ai][bj][m][1] * c1;
                        u32x4 w; w.x = pk2(v0[0], v0[1]); w.y = pk2(v0[2], v0[3]); w.z = pk2(v1[0], v1[1]); w.w = pk2(v1[2], v1[3]); *(u32x4*)(MG + (size_t)row * D + col) = w; }
                } }
    }
};
struct EpiRes {
    static constexpr bool PERM = true, AFTER_DRAIN = false, KEEP = false;
    unsigned char* ws; int layer, goff;
    __device__ __forceinline__ void operator()(const f32x4 (&acc)[2][2][4][2], const pg8::Unit& u, int wr, int wc, int fr, int fq) const {
        bf16_t* X = (bf16_t*)(ws + WS_X); const float* MOD = (const float*)(ws + WS_MOD);
#pragma unroll
        for (int ai = 0; ai < 2; ++ai)
#pragma unroll
            for (int m = 0; m < 4; ++m) { const int row = u.pm * 256 + ai * 128 + wr * 64 + m * 16 + fr;
                const float* gate = MOD + (size_t)(layer * 5 + mod_vec_of_row(row)) * 12288 + goff;
#pragma unroll
                for (int bj = 0; bj < 2; ++bj) { const int col = u.pn * 256 + bj * 128 + wc * 32 + 8 * fq;
                    bf16_t* x = X + (size_t)row * D + col;
                    const f32x4 g0 = *(const f32x4*)(gate + col), g1 = *(const f32x4*)(gate + col + 4);
                    const u32x4 p = *(const u32x4*)x;
                    const f32x4 y0 = (f32x4){bf_lo(p.x), bf_hi(p.x), bf_lo(p.y), bf_hi(p.y)} + g0 * acc[ai][bj][m][0], y1 = (f32x4){bf_lo(p.z), bf_hi(p.z), bf_lo(p.w), bf_hi(p.w)} + g1 * acc[ai][bj][m][1];
                    u32x4 w; w.x = pk2(y0.x, y0.y); w.y = pk2(y0.z, y0.w); w.z = pk2(y1.x, y1.y); w.w = pk2(y1.z, y1.w); *(u32x4*)x = w; } }
    }
};
struct EpiRelu2 {
    static constexpr bool PERM = true, AFTER_DRAIN = false, KEEP = false;
    unsigned char* ws;
    __device__ __forceinline__ void operator()(const f32x4 (&acc)[2][2][4][2], const pg8::Unit& u, int wr, int wc, int fr, int fq) const {
        bf16_t* FH = (bf16_t*)(ws + WS_FFH);
#pragma unroll
        for (int ai = 0; ai < 2; ++ai)
#pragma unroll
            for (int m = 0; m < 4; ++m) { const int row = u.pm * 256 + ai * 128 + wr * 64 + m * 16 + fr;
#pragma unroll
                for (int bj = 0; bj < 2; ++bj) { const int col = u.pn * 256 + bj * 128 + wc * 32 + 8 * fq;
                    f32x4 v0 = acc[ai][bj][m][0], v1 = acc[ai][bj][m][1];
                    v0 = __builtin_elementwise_max(v0, (f32x4){0.f, 0.f, 0.f, 0.f}); v1 = __builtin_elementwise_max(v1, (f32x4){0.f, 0.f, 0.f, 0.f}); v0 *= v0; v1 *= v1;
                    u32x4 w; w.x = pk2(v0[0], v0[1]); w.y = pk2(v0[2], v0[3]); w.z = pk2(v1[0], v1[1]); w.w = pk2(v1[2], v1[3]);
                    *(u32x4*)(FH + (size_t)row * DFF + col) = w; } }
    }
};

__device__ __forceinline__ void phase_gdn_prep(KArgs& a, int l) {
    const int tid = otid(), lane = tid & 63, wave = tid >> 6, gw = blockIdx.x * 8 + wave, NGW = gridDim.x * 8;
    const int sub = lane >> 4, l16 = lane & 15;
    const bf16_t* RAW = (const bf16_t*)(a.ws + WS_GQKV);
    const float* CW = a.in[16] + (size_t)l * 9 * 3072;
    for (int it0 = gw * 4 + sub; it0 < NTOK * 24; it0 += NGW * 8) {
        int r[2], ch[2], c[2], t[2]; bool ok[2], ctx[2]; float y[2][8];
#pragma unroll
        for (int u = 0; u < 2; ++u) { const int it = it0 + u * NGW * 4; ok[u] = it < NTOK * 24; const int itc = ok[u] ? it : it0;
            r[u] = itc / 24; ch[u] = itc - r[u] * 24; c[u] = ch[u] * 128 + 8 * l16; ctx[u] = r[u] < NCTX; t[u] = ctx[u] ? (r[u] & 255) : ((r[u] - NCTX) & 1023);
#pragma unroll
            for (int e = 0; e < 8; ++e) y[u][e] = 0.f; }
#pragma unroll
        for (int i = 0; i < 3; ++i)
#pragma unroll
            for (int j = 0; j < 3; ++j)
#pragma unroll
                for (int u = 0; u < 2; ++u) {
                    bool valid; int dr;
                    if (ctx[u]) { const int tt = t[u] + j - 1; valid = (i == 1) && tt >= 0 && tt < 256; dr = j - 1; }
                    else { const int rr = (t[u] >> 6) + i - 1, cc = (t[u] & 63) + j - 1; valid = rr >= 0 && rr < 16 && cc >= 0 && cc < 64; dr = (i - 1) * 64 + (j - 1); }
                    if (valid && ok[u]) { const u32x4 w = *(const u32x4*)(RAW + (size_t)(r[u] + dr) * 3072 + c[u]);
                        const f32x4 c0 = *(const f32x4*)(CW + (i * 3 + j) * 3072 + c[u]), c1 = *(const f32x4*)(CW + (i * 3 + j) * 3072 + c[u] + 4);
                        y[u][0] += c0.x * bf_lo(w.x); y[u][1] += c0.y * bf_hi(w.x); y[u][2] += c0.z * bf_lo(w.y); y[u][3] += c0.w * bf_hi(w.y);
                        y[u][4] += c1.x * bf_lo(w.z); y[u][5] += c1.y * bf_hi(w.z); y[u][6] += c1.z * bf_lo(w.w); y[u][7] += c1.w * bf_hi(w.w); }
                }
#pragma unroll
        for (int u = 0; u < 2; ++u) {
            float ss = 0.f;
#pragma unroll
            for (int e = 0; e < 8; ++e) { y[u][e] = siluf_(y[u][e]); ss += y[u][e] * y[u][e]; }
            ss = red16(ss);
            float sc = 1.0f;
            if (ch[u] < 16) sc = rsqrtf(ss + EPS) * (ch[u] < 8 ? 0.08838834764831845f : 1.0f);
            if (ok[u]) { bf16_t* dst = (bf16_t*)(a.ws + (ch[u] < 8 ? WS_GQ : (ch[u] < 16 ? WS_GK : WS_GV))) + (size_t)r[u] * 1024 + (ch[u] & 7) * 128 + 8 * l16;
                u32x4 o; o.x = pk2(y[u][0] * sc, y[u][1] * sc); o.y = pk2(y[u][2] * sc, y[u][3] * sc); o.z = pk2(y[u][4] * sc, y[u][5] * sc); o.w = pk2(y[u][6] * sc, y[u][7] * sc); *(u32x4*)dst = o; }
        }
    }
}

constexpr int HC_QT = 0, HC_KT = 4352, HC_KD = 8704, HC_VT = 18944, HC_G = 29184, HC_BUF = 29696, HC_TOT = 2 * HC_BUF;
__device__ __forceinline__ void hgrn_chunk_item(KArgs& a, LAS unsigned char* lds, int l, int s, int h, int dir) {
    const int tid = otid(), lane = tid & 63, w = tid >> 6, fr = lane & 15, fq = lane >> 4;
    const int d = tid & 127, part = tid >> 7;
    const int L = (s < 16) ? 256 : 1024, row0 = (s < 16) ? s * 256 : NCTX + (s - 16) * 1024, nchunk = L / 16;
    f32x4 acc[8];
    if (s >= 16) { const float* st = a.in[3] + ((((size_t)(s - 16) * 2 + l) * 2 + dir) * 8 + h) * 16384;
#pragma unroll
        for (int dt = 0; dt < 8; ++dt)
#pragma unroll
            for (int jj = 0; jj < 4; ++jj) acc[dt][jj] = st[(16 * dt + 4 * fq + jj) * 128 + 16 * w + fr]; }
    else {
#pragma unroll
        for (int dt = 0; dt < 8; ++dt) acc[dt] = (f32x4){0.f, 0.f, 0.f, 0.f}; }
    const float* F = (const float*)(a.ws + (dir ? WS_FB : WS_FF));
    const bf16_t* HQ = (const bf16_t*)(a.ws + WS_HQ); const bf16_t* HI = (const bf16_t*)(a.ws + WS_HI);
    bf16_t* OS = (bf16_t*)(a.ws + WS_OSH) + (size_t)dir * NTOK * 1024;
    LAS float* TOT = (LAS float*)(lds + HC_TOT);
    float pf[4]; unsigned pq[4], pv[4];
#define HC_ROW(c, j) (row0 + (dir ? L - 1 - (16 * (c) + (j)) : 16 * (c) + (j)))
#define HC_PREFETCH(c) do { _Pragma("unroll") for (int i = 0; i < 4; ++i) { const size_t o_ = (size_t)HC_ROW(c, 4 * part + i) * 1024 + h * 128 + d; pf[i] = F[o_]; pq[i] = HQ[o_]; pv[i] = HI[o_]; } } while (0)
    HC_PREFETCH(0);
    float cs[4], omf[4], qf[4];
    { LAS unsigned char* B = lds;
        { float run = 0.f;
#pragma unroll
          for (int i = 0; i < 4; ++i) { run += __logf(fmaxf(pf[i], 1e-30f)); cs[i] = run; omf[i] = 1.0f - pf[i]; qf[i] = __builtin_bit_cast(float, pq[i] << 16); } }
        TOT[part * 128 + d] = cs[3];
        { u32x2 t; t.x = pv[0] | (pv[1] << 16); t.y = pv[2] | (pv[3] << 16); *(LAS u32x2*)(B + HC_VT + d * 80 + 8 * part) = t; }
        if (1 < nchunk) HC_PREFETCH(1);
        LDS_BARRIER();
        { const float t0 = TOT[d], t1 = TOT[128 + d], t2 = TOT[256 + d], t3 = TOT[384 + d];
          const float pre = (part > 0 ? t0 : 0.f) + (part > 1 ? t1 : 0.f) + (part > 2 ? t2 : 0.f), blast = (t0 + t1) + (t2 + t3);
          float kd[4];
#pragma unroll
          for (int i = 0; i < 4; ++i) { const float b = pre + cs[i];
              const unsigned qk = pk2(qf[i] * __expf(b), omf[i] * __expf(fminf(-b, 80.0f)));
              ((LAS bf16_t*)(B + HC_QT))[(4 * part + i) * 136 + d] = (bf16_t)(qk & 0xffffu);
              ((LAS bf16_t*)(B + HC_KT))[(4 * part + i) * 136 + d] = (bf16_t)(qk >> 16);
              kd[i] = omf[i] * __expf(blast - b); }
          { u32x2 t; t.x = pk2(kd[0], kd[1]); t.y = pk2(kd[2], kd[3]); *(LAS u32x2*)(B + HC_KD + d * 80 + 8 * part) = t; }
          if (part == 0) ((LAS float*)(B + HC_G))[d] = __expf(blast); }
        LDS_BARRIER(); }
    for (int c = 0; c < nchunk; ++c) {
        const bool hn = c + 1 < nchunk;
        if (hn) { LAS unsigned char* B = lds + ((c + 1) & 1) * HC_BUF;
        { float run = 0.f;
#pragma unroll
          for (int i = 0; i < 4; ++i) { run += __logf(fmaxf(pf[i], 1e-30f)); cs[i] = run; omf[i] = 1.0f - pf[i]; qf[i] = __builtin_bit_cast(float, pq[i] << 16); } }
        TOT[part * 128 + d] = cs[3];
        { u32x2 t; t.x = pv[0] | (pv[1] << 16); t.y = pv[2] | (pv[3] << 16); *(LAS u32x2*)(B + HC_VT + d * 80 + 8 * part) = t; }
            if (c + 2 < nchunk) HC_PREFETCH(c + 2); }
        LDS_BARRIER();
        if (hn) { LAS unsigned char* B = lds + ((c + 1) & 1) * HC_BUF;
        { const float t0 = TOT[d], t1 = TOT[128 + d], t2 = TOT[256 + d], t3 = TOT[384 + d];
          const float pre = (part > 0 ? t0 : 0.f) + (part > 1 ? t1 : 0.f) + (part > 2 ? t2 : 0.f), blast = (t0 + t1) + (t2 + t3);
          float kd[4];
#pragma unroll
          for (int i = 0; i < 4; ++i) { const float b = pre + cs[i];
              const unsigned qk = pk2(qf[i] * __expf(b), omf[i] * __expf(fminf(-b, 80.0f)));
              ((LAS bf16_t*)(B + HC_QT))[(4 * part + i) * 136 + d] = (bf16_t)(qk & 0xffffu);
              ((LAS bf16_t*)(B + HC_KT))[(4 * part + i) * 136 + d] = (bf16_t)(qk >> 16);
              kd[i] = omf[i] * __expf(blast - b); }
          { u32x2 t; t.x = pk2(kd[0], kd[1]); t.y = pk2(kd[2], kd[3]); *(LAS u32x2*)(B + HC_KD + d * 80 + 8 * part) = t; }
          if (part == 0) ((LAS float*)(B + HC_G))[d] = __expf(blast); }
        }
        { LAS unsigned char* B = lds + (c & 1) * HC_BUF;
        f32x4 A = (f32x4){0.f, 0.f, 0.f, 0.f};
#pragma unroll
        for (int ks = 0; ks < 4; ++ks) { const bf16x8 kf = *(const LAS bf16x8*)(B + HC_KT + fr * 272 + 64 * ks + 16 * fq), qfr = *(const LAS bf16x8*)(B + HC_QT + fr * 272 + 64 * ks + 16 * fq);
            A = __builtin_amdgcn_mfma_f32_16x16x32_bf16(kf, qfr, A, 0, 0, 0); }
#pragma unroll
        for (int jj = 0; jj < 4; ++jj) if (4 * fq + jj > fr) A[jj] = 0.f;
        u32x4 af; af.x = pk2(A[0], A[1]); af.y = pk2(A[2], A[3]); af.z = 0u; af.w = 0u;
        u32x4 vf; { const u32x2 t = *(const LAS u32x2*)(B + HC_VT + (16 * w + fr) * 80 + 8 * fq); vf.x = t.x; vf.y = t.y; vf.z = 0u; vf.w = 0u; }
        f32x4 o = __builtin_amdgcn_mfma_f32_16x16x32_bf16(__builtin_bit_cast(bf16x8, af), __builtin_bit_cast(bf16x8, vf), (f32x4){0.f, 0.f, 0.f, 0.f}, 0, 0, 0);
#pragma unroll
        for (int ks = 0; ks < 4; ++ks) {
            const u32x2 qa = *(const LAS u32x2*)(B + HC_QT + fr * 272 + 64 * ks + 8 * fq), qb = *(const LAS u32x2*)(B + HC_QT + fr * 272 + 64 * ks + 32 + 8 * fq);
            u32x4 q2; q2.x = qa.x; q2.y = qa.y; q2.z = qb.x; q2.w = qb.y;
            u32x4 sf; sf.x = pk2(acc[2 * ks][0], acc[2 * ks][1]); sf.y = pk2(acc[2 * ks][2], acc[2 * ks][3]); sf.z = pk2(acc[2 * ks + 1][0], acc[2 * ks + 1][1]); sf.w = pk2(acc[2 * ks + 1][2], acc[2 * ks + 1][3]);
            o = __builtin_amdgcn_mfma_f32_16x16x32_bf16(__builtin_bit_cast(bf16x8, q2), __builtin_bit_cast(bf16x8, sf), o, 0, 0, 0); }
#pragma unroll
        for (int jj = 0; jj < 4; jj += 2) { const unsigned op = pk2(o[jj], o[jj + 1]);
            OS[(size_t)HC_ROW(c, 4 * fq + jj) * 1024 + h * 128 + 16 * w + fr] = (bf16_t)(op & 0xffffu); OS[(size_t)HC_ROW(c, 4 * fq + jj + 1) * 1024 + h * 128 + 16 * w + fr] = (bf16_t)(op >> 16); }
#pragma unroll
        for (int dt = 0; dt < 8; ++dt) { const f32x4 g4 = *(const LAS f32x4*)(B + HC_G + (16 * dt + 4 * fq) * 4);
            u32x4 kf; { const u32x2 t = *(const LAS u32x2*)(B + HC_KD + (16 * dt + fr) * 80 + 8 * fq); kf.x = t.x; kf.y = t.y; kf.z = 0u; kf.w = 0u; }
            acc[dt] = __builtin_amdgcn_mfma_f32_16x16x32_bf16(__builtin_bit_cast(bf16x8, kf), __builtin_bit_cast(bf16x8, vf), acc[dt] * g4, 0, 0, 0); }
        }
        LDS_BARRIER();
    }
#undef HC_ROW
#undef HC_PREFETCH
    if (s < 16) { float* so = a.out + OUT_SHG + ((((size_t)s * 2 + l) * 2 + dir) * 8 + h) * 16384;
#pragma unroll
        for (int dt = 0; dt < 8; ++dt)
#pragma unroll
            for (int jj = 0; jj < 4; ++jj) so[(16 * dt + 4 * fq + jj) * 128 + 16 * w + fr] = acc[dt][jj]; }
    __syncthreads();
}


constexpr int GC_KT = 0, GC_QT = 4352, GC_V = 8704, GC_KD = 16896, GC_GS = 27136, GC_BS = 27200, GC_GC = 27264, GC_EG = 27328, GC_AQ = 27392, GC_TT = 27904, GC_BUF = 28416, GC_PRIV = 2 * GC_BUF;
static_assert(GC_PRIV + 1024 <= LDS_MISC, "GDN chunk LDS map");
__device__ __forceinline__ void gdn_chunk_item(KArgs& a, LAS unsigned char* lds, int l, int s, int h, int dir) {
    const int tid = otid(), lane = tid & 63, w = tid >> 6, fr = lane & 15, fq = lane >> 4;
    const int d = tid & 127, part = tid >> 7;
    const int L = (s < 16) ? 256 : 1024, row0 = (s < 16) ? s * 256 : NCTX + (s - 16) * 1024, nchunk = L / 16;
    f32x4 acc[8];
    if (s >= 16) { const float* st = a.in[4] + ((((size_t)(s - 16) * 2 + l) * 2 + dir) * 8 + h) * 16384;
#pragma unroll
        for (int dt = 0; dt < 8; ++dt)
#pragma unroll
            for (int jj = 0; jj < 4; ++jj) acc[dt][jj] = st[(16 * dt + 4 * fq + jj) * 128 + 16 * w + fr]; }
    else {
#pragma unroll
        for (int dt = 0; dt < 8; ++dt) acc[dt] = (f32x4){0.f, 0.f, 0.f, 0.f}; }
    const bf16_t* GK = (const bf16_t*)(a.ws + WS_GK); const bf16_t* GQ = (const bf16_t*)(a.ws + WS_GQ); const bf16_t* GV = (const bf16_t*)(a.ws + WS_GV); const float* GAB = (const float*)(a.ws + WS_GAB);
    bf16_t* OS = (bf16_t*)(a.ws + WS_OSG) + (size_t)dir * NTOK * 1024;
    LAS float* KKs = (LAS float*)(lds + GC_PRIV);
    unsigned pk_[4], pq_[4], pv_[4]; float pg_ = 0.f, pb_ = 0.f;
#define GC_ROW(c, j) (row0 + (dir ? L - 1 - (16 * (c) + (j)) : 16 * (c) + (j)))
#define GC_PREFETCH(c) do { _Pragma("unroll") for (int i = 0; i < 4; ++i) { const size_t o_ = (size_t)GC_ROW(c, 4 * part + i) * 1024 + h * 128 + d; pk_[i] = GK[o_]; pq_[i] = GQ[o_]; pv_[i] = GV[o_]; } \
        if (tid < 16) { const size_t r_ = (size_t)GC_ROW(c, tid) * 32; pg_ = GAB[r_ + dir * 8 + h]; pb_ = GAB[r_ + 16 + dir * 8 + h]; } } while (0)
#define GC_TSTAGE(Bp) do { LAS unsigned char* Bt_ = (Bp); \
        const LAS float* GCa_ = (const LAS float*)(Bt_ + GC_GC); const LAS float* BSa_ = (const LAS float*)(Bt_ + GC_BS); \
        f32x4 Gm_ = (f32x4){0.f, 0.f, 0.f, 0.f}, Aq_ = Gm_; \
        _Pragma("unroll") for (int ks = 0; ks < 4; ++ks) { const bf16x8 kfr_ = *(const LAS bf16x8*)(Bt_ + GC_KT + fr * 272 + 64 * ks + 16 * fq), qfr_ = *(const LAS bf16x8*)(Bt_ + GC_QT + fr * 272 + 64 * ks + 16 * fq); \
            Gm_ = __builtin_amdgcn_mfma_f32_16x16x32_bf16(kfr_, kfr_, Gm_, 0, 0, 0); Aq_ = __builtin_amdgcn_mfma_f32_16x16x32_bf16(kfr_, qfr_, Aq_, 0, 0, 0); } \
        const float gct_ = GCa_[fr], bet_ = BSa_[fr]; const f32x4 gc4_ = *(const LAS f32x4*)(GCa_ + 4 * fq); \
        f32x4 KK_; \
        _Pragma("unroll") for (int jj = 0; jj < 4; ++jj) { const float dec_ = __expf(fminf(gct_ - gc4_[jj], 0.f)); const int sidx_ = 4 * fq + jj; \
            KK_[jj] = (sidx_ < fr) ? bet_ * Gm_[jj] * dec_ : 0.f; Aq_[jj] = (sidx_ <= fr) ? Aq_[jj] * dec_ : 0.f; } \
        *(LAS f32x4*)(KKs + fr * 16 + 4 * fq) = KK_; \
        { u32x2 t_; t_.x = pk2(Aq_[0], Aq_[1]); t_.y = pk2(Aq_[2], Aq_[3]); *(LAS u32x2*)(Bt_ + GC_AQ + fr * 32 + 8 * fq) = t_; } \
        asm volatile("s_waitcnt lgkmcnt(0)" ::: "memory"); \
        float x_[16]; \
        _Pragma("unroll") for (int t = 0; t < 16; ++t) x_[t] = (t == fr) ? 1.0f : 0.0f; \
        _Pragma("unroll") for (int t = 1; t < 16; ++t) { float sa_ = 0.f; \
            _Pragma("unroll") for (int sb = 0; sb < (t + 3) / 4; ++sb) { const f32x4 kk_ = *(const LAS f32x4*)(KKs + t * 16 + 4 * sb); \
                sa_ += (kk_.x * x_[4 * sb] + kk_.y * x_[4 * sb + 1]) + (kk_.z * x_[4 * sb + 2] + kk_.w * x_[4 * sb + 3]); } \
            x_[t] -= sa_; } \
        _Pragma("unroll") for (int e = 0; e < 4; e += 2) { \
            const float ta_ = (fq == 0) ? x_[e] : ((fq == 1) ? x_[4 + e] : ((fq == 2) ? x_[8 + e] : x_[12 + e])); \
            const float tb_ = (fq == 0) ? x_[e + 1] : ((fq == 1) ? x_[5 + e] : ((fq == 2) ? x_[9 + e] : x_[13 + e])); \
            const unsigned tp_ = pk2(ta_, tb_); \
            ((LAS bf16_t*)(Bt_ + GC_TT))[(4 * fq + e) * 16 + fr] = (bf16_t)(tp_ & 0xffffu); ((LAS bf16_t*)(Bt_ + GC_TT))[(4 * fq + e + 1) * 16 + fr] = (bf16_t)(tp_ >> 16); } \
    } while (0)
    GC_PREFETCH(0);
    float kf[4];
    { LAS unsigned char* B = lds;
#pragma unroll
        for (int i = 0; i < 4; ++i) { kf[i] = __builtin_bit_cast(float, pk_[i] << 16);
            ((LAS bf16_t*)(B + GC_KT))[(4 * part + i) * 136 + d] = (bf16_t)pk_[i];
            ((LAS bf16_t*)(B + GC_QT))[(4 * part + i) * 136 + d] = (bf16_t)pq_[i];
            ((LAS float*)(B + GC_V))[(4 * part + i) * 128 + d] = __builtin_bit_cast(float, pv_[i] << 16); }
        if (tid < 16) { ((LAS float*)(B + GC_GS))[tid] = pg_; ((LAS float*)(B + GC_BS))[tid] = pb_; }
        if (1 < nchunk) GC_PREFETCH(1);
        LDS_BARRIER();
        { const LAS float* GS = (const LAS float*)(B + GC_GS);
          const f32x4 g0 = *(const LAS f32x4*)(GS), g1 = *(const LAS f32x4*)(GS + 4), g2 = *(const LAS f32x4*)(GS + 8), g3 = *(const LAS f32x4*)(GS + 12);
          const float s0 = (g0.x + g0.y) + (g0.z + g0.w), s1 = (g1.x + g1.y) + (g1.z + g1.w), s2 = (g2.x + g2.y) + (g2.z + g2.w), s3 = (g3.x + g3.y) + (g3.z + g3.w);
          const float glast = (s0 + s1) + (s2 + s3);
          { const float pre = (part > 0 ? s0 : 0.f) + (part > 1 ? s1 : 0.f) + (part > 2 ? s2 : 0.f);
            const f32x4 gl = *(const LAS f32x4*)(GS + 4 * part);
            const float c0 = pre + gl.x, c1 = c0 + gl.y, c2 = c1 + gl.z, c3 = c2 + gl.w;
            u32x2 t; t.x = pk2(kf[0] * __expf(glast - c0), kf[1] * __expf(glast - c1)); t.y = pk2(kf[2] * __expf(glast - c2), kf[3] * __expf(glast - c3));
            *(LAS u32x2*)(B + GC_KD + d * 80 + 8 * part) = t; }
          if (tid < 16) { const int p2 = tid >> 2, i2 = tid & 3;
            const float pre = (p2 > 0 ? s0 : 0.f) + (p2 > 1 ? s1 : 0.f) + (p2 > 2 ? s2 : 0.f);
            const f32x4 gl = *(const LAS f32x4*)(GS + 4 * p2);
            const float c0 = pre + gl.x, c1 = c0 + gl.y, c2 = c1 + gl.z, c3 = c2 + gl.w;
            const float gcv = (i2 == 0) ? c0 : ((i2 == 1) ? c1 : ((i2 == 2) ? c2 : c3));
            ((LAS float*)(B + GC_GC))[tid] = gcv; ((LAS float*)(B + GC_EG))[tid] = __expf(gcv); } }
        if (w == 0) GC_TSTAGE(B);
        LDS_BARRIER(); }
    for (int c = 0; c < nchunk; ++c) {
        const bool hn = c + 1 < nchunk;
        if (hn) { LAS unsigned char* B = lds + ((c + 1) & 1) * GC_BUF;
#pragma unroll
        for (int i = 0; i < 4; ++i) { kf[i] = __builtin_bit_cast(float, pk_[i] << 16);
            ((LAS bf16_t*)(B + GC_KT))[(4 * part + i) * 136 + d] = (bf16_t)pk_[i];
            ((LAS bf16_t*)(B + GC_QT))[(4 * part + i) * 136 + d] = (bf16_t)pq_[i];
            ((LAS float*)(B + GC_V))[(4 * part + i) * 128 + d] = __builtin_bit_cast(float, pv_[i] << 16); }
        if (tid < 16) { ((LAS float*)(B + GC_GS))[tid] = pg_; ((LAS float*)(B + GC_BS))[tid] = pb_; }
            if (c + 2 < nchunk) GC_PREFETCH(c + 2); }
        LDS_BARRIER();
        if (hn) { LAS unsigned char* B = lds + ((c + 1) & 1) * GC_BUF;
        { const LAS float* GS = (const LAS float*)(B + GC_GS);
          const f32x4 g0 = *(const LAS f32x4*)(GS), g1 = *(const LAS f32x4*)(GS + 4), g2 = *(const LAS f32x4*)(GS + 8), g3 = *(const LAS f32x4*)(GS + 12);
          const float s0 = (g0.x + g0.y) + (g0.z + g0.w), s1 = (g1.x + g1.y) + (g1.z + g1.w), s2 = (g2.x + g2.y) + (g2.z + g2.w), s3 = (g3.x + g3.y) + (g3.z + g3.w);
          const float glast = (s0 + s1) + (s2 + s3);
          { const float pre = (part > 0 ? s0 : 0.f) + (part > 1 ? s1 : 0.f) + (part > 2 ? s2 : 0.f);
            const f32x4 gl = *(const LAS f32x4*)(GS + 4 * part);
            const float c0 = pre + gl.x, c1 = c0 + gl.y, c2 = c1 + gl.z, c3 = c2 + gl.w;
            u32x2 t; t.x = pk2(kf[0] * __expf(glast - c0), kf[1] * __expf(glast - c1)); t.y = pk2(kf[2] * __expf(glast - c2), kf[3] * __expf(glast - c3));
            *(LAS u32x2*)(B + GC_KD + d * 80 + 8 * part) = t; }
          if (tid < 16) { const int p2 = tid >> 2, i2 = tid & 3;
            const float pre = (p2 > 0 ? s0 : 0.f) + (p2 > 1 ? s1 : 0.f) + (p2 > 2 ? s2 : 0.f);
            const f32x4 gl = *(const LAS f32x4*)(GS + 4 * p2);
            const float c0 = pre + gl.x, c1 = c0 + gl.y, c2 = c1 + gl.z, c3 = c2 + gl.w;
            const float gcv = (i2 == 0) ? c0 : ((i2 == 1) ? c1 : ((i2 == 2) ? c2 : c3));
            ((LAS float*)(B + GC_GC))[tid] = gcv; ((LAS float*)(B + GC_EG))[tid] = __expf(gcv); } }
        if (w == 0) GC_TSTAGE(B);
        }
        { LAS unsigned char* B = lds + (c & 1) * GC_BUF;
        const LAS float* EGa = (const LAS float*)(B + GC_EG); const LAS float* BSa = (const LAS float*)(B + GC_BS);
        const f32x4 eg4 = *(const LAS f32x4*)(EGa + 4 * fq), be4 = *(const LAS f32x4*)(BSa + 4 * fq);
        const float egl = EGa[15];
        u32x4 af; { const u32x2 t = *(const LAS u32x2*)(B + GC_AQ + fr * 32 + 8 * fq); af.x = t.x; af.y = t.y; af.z = 0u; af.w = 0u; }
        u32x4 tf; { const u32x2 t = *(const LAS u32x2*)(B + GC_TT + fr * 32 + 8 * fq); tf.x = t.x; tf.y = t.y; tf.z = 0u; tf.w = 0u; }
        f32x4 P = (f32x4){0.f, 0.f, 0.f, 0.f}, QS = P;
#pragma unroll
        for (int ks = 0; ks < 4; ++ks) {
            const u32x2 ka = *(const LAS u32x2*)(B + GC_KT + fr * 272 + 64 * ks + 8 * fq), kb = *(const LAS u32x2*)(B + GC_KT + fr * 272 + 64 * ks + 32 + 8 * fq);
            const u32x2 qa = *(const LAS u32x2*)(B + GC_QT + fr * 272 + 64 * ks + 8 * fq), qb = *(const LAS u32x2*)(B + GC_QT + fr * 272 + 64 * ks + 32 + 8 * fq);
            u32x4 k2; k2.x = ka.x; k2.y = ka.y; k2.z = kb.x; k2.w = kb.y; u32x4 q2; q2.x = qa.x; q2.y = qa.y; q2.z = qb.x; q2.w = qb.y;
            u32x4 sf; sf.x = pk2(acc[2 * ks][0], acc[2 * ks][1]); sf.y = pk2(acc[2 * ks][2], acc[2 * ks][3]); sf.z = pk2(acc[2 * ks + 1][0], acc[2 * ks + 1][1]); sf.w = pk2(acc[2 * ks + 1][2], acc[2 * ks + 1][3]);
            P = __builtin_amdgcn_mfma_f32_16x16x32_bf16(__builtin_bit_cast(bf16x8, k2), __builtin_bit_cast(bf16x8, sf), P, 0, 0, 0);
            QS = __builtin_amdgcn_mfma_f32_16x16x32_bf16(__builtin_bit_cast(bf16x8, q2), __builtin_bit_cast(bf16x8, sf), QS, 0, 0, 0); }
        float Rr[4];
#pragma unroll
        for (int jj = 0; jj < 4; ++jj) { const float vv = ((const LAS float*)(B + GC_V))[(4 * fq + jj) * 128 + 16 * w + fr]; Rr[jj] = be4[jj] * (vv - eg4[jj] * P[jj]); }
        u32x4 rf; rf.x = pk2(Rr[0], Rr[1]); rf.y = pk2(Rr[2], Rr[3]); rf.z = 0u; rf.w = 0u;
        const f32x4 vn = __builtin_amdgcn_mfma_f32_16x16x32_bf16(__builtin_bit_cast(bf16x8, tf), __builtin_bit_cast(bf16x8, rf), (f32x4){0.f, 0.f, 0.f, 0.f}, 0, 0, 0);
        u32x4 vf; vf.x = pk2(vn[0], vn[1]); vf.y = pk2(vn[2], vn[3]); vf.z = 0u; vf.w = 0u;
        const f32x4 oi = __builtin_amdgcn_mfma_f32_16x16x32_bf16(__builtin_bit_cast(bf16x8, af), __builtin_bit_cast(bf16x8, vf), (f32x4){0.f, 0.f, 0.f, 0.f}, 0, 0, 0);
#pragma unroll
        for (int jj = 0; jj < 4; jj += 2) { const unsigned op = pk2(eg4[jj] * QS[jj] + oi[jj], eg4[jj + 1] * QS[jj + 1] + oi[jj + 1]);
            OS[(size_t)GC_ROW(c, 4 * fq + jj) * 1024 + h * 128 + 16 * w + fr] = (bf16_t)(op & 0xffffu); OS[(size_t)GC_ROW(c, 4 * fq + jj + 1) * 1024 + h * 128 + 16 * w + fr] = (bf16_t)(op >> 16); }
#pragma unroll
        for (int dt = 0; dt < 8; ++dt) {
            u32x4 kdf; { const u32x2 t = *(const LAS u32x2*)(B + GC_KD + (16 * dt + fr) * 80 + 8 * fq); kdf.x = t.x; kdf.y = t.y; kdf.z = 0u; kdf.w = 0u; }
            acc[dt] = __builtin_amdgcn_mfma_f32_16x16x32_bf16(__builtin_bit_cast(bf16x8, kdf), __builtin_bit_cast(bf16x8, vf), acc[dt] * egl, 0, 0, 0); }
        }
        LDS_BARRIER();
    }
#undef GC_ROW
#undef GC_PREFETCH
#undef GC_TSTAGE
    if (s < 16) { float* so = a.out + OUT_SGDN + ((((size_t)s * 2 + l) * 2 + dir) * 8 + h) * 16384;
#pragma unroll
        for (int dt = 0; dt < 8; ++dt)
#pragma unroll
            for (int jj = 0; jj < 4; ++jj) so[(16 * dt + 4 * fq + jj) * 128 + 16 * w + fr] = acc[dt][jj]; }
    __syncthreads();
}

__device__ __forceinline__ void gmlp_item(KArgs& a, LAS unsigned char* lds, int l, int chunk, int g) {
    const int tid = otid(), lane = tid & 63, w = tid >> 6, row0 = chunk * 128;
    LAS bf16_t* vT = (LAS bf16_t*)lds;
    { const int q = tid >> 2, part = tid & 3;
      const bf16_t* src = (const bf16_t*)(a.ws + WS_CV) + (size_t)(row0 + q) * 1024 + g * 128 + part * 32;
      float x[32]; float ss = 0.f;
#pragma unroll
      for (int i = 0; i < 4; ++i) { const u32x4 r = ((const u32x4*)src)[i];
          x[8 * i] = bf_lo(r.x); x[8 * i + 1] = bf_hi(r.x); x[8 * i + 2] = bf_lo(r.y); x[8 * i + 3] = bf_hi(r.y); x[8 * i + 4] = bf_lo(r.z); x[8 * i + 5] = bf_hi(r.z); x[8 * i + 6] = bf_lo(r.w); x[8 * i + 7] = bf_hi(r.w); }
#pragma unroll
      for (int i = 0; i < 32; ++i) ss += x[i] * x[i];
      ss += __shfl_xor(ss, 1); ss += __shfl_xor(ss, 2);
      const float rstd = rsqrtf(ss * (1.0f / 128.0f) + EPS);
      const float* gn = a.in[13] + l * 1024 + g * 128 + part * 32;
#pragma unroll
      for (int i = 0; i < 32; ++i) vT[(part * 32 + i) * 136 + q] = (bf16_t)f2bf(x[i] * rstd * gn[i]);
    }
    __syncthreads();
    const int fr = lane & 15, fq = lane >> 4, p = 16 * w + fr;
    const float* wsrow = a.in[14] + (((size_t)l * 8 + g) * 128 + p) * 128;
    bf16x8 bw[4];
#pragma unroll
    for (int ks = 0; ks < 4; ++ks) { const f32x4 x0 = *(const f32x4*)(wsrow + ks * 32 + 8 * fq), x1 = *(const f32x4*)(wsrow + ks * 32 + 8 * fq + 4);
        u32x4 t; t.x = pk2(x0.x, x0.y); t.y = pk2(x0.z, x0.w); t.z = pk2(x1.x, x1.y); t.w = pk2(x1.z, x1.w); bw[ks] = __builtin_bit_cast(bf16x8, t); }
    const float bias = a.in[15][((size_t)l * 8 + g) * 128 + p];
    const bf16_t* CU = (const bf16_t*)(a.ws + WS_CU); bf16_t* OB = (bf16_t*)(a.ws + WS_OB);
#pragma unroll
    for (int ct = 0; ct < 8; ++ct) {
        f32x4 acc = (f32x4){0.f, 0.f, 0.f, 0.f};
#pragma unroll
        for (int ks = 0; ks < 4; ++ks) { const bf16x8 av = *(const LAS bf16x8*)(vT + (ct * 16 + fr) * 136 + ks * 32 + 8 * fq);
            acc = __builtin_amdgcn_mfma_f32_16x16x32_bf16(av, bw[ks], acc, 0, 0, 0); }
        const size_t o = (size_t)(row0 + p) * 1024 + g * 128 + ct * 16 + 4 * fq;
        const u32x2 uu = *(const u32x2*)(CU + o);
        u32x2 r; r.x = pk2(bf_lo(uu.x) * (acc[0] + bias), bf_hi(uu.x) * (acc[1] + bias)); r.y = pk2(bf_lo(uu.y) * (acc[2] + bias), bf_hi(uu.y) * (acc[3] + bias));
        *(u32x2*)(OB + o) = r;
    }
    __syncthreads();
}

__device__ __forceinline__ void phase_mixers(KArgs& a, LAS unsigned char* lds, int lq) {
    const int l = lq & 1;
    unsigned* head = (unsigned*)(a.ws + WS_CTL) + CW_QUEUE + 64 * lq;
    volatile LAS unsigned* slot = (volatile LAS unsigned*)(lds + LDS_MISC);
    for (;;) {
        if (otid() == 0) slot[0] = __hip_atomic_fetch_add(head, 1u, __ATOMIC_RELAXED, __HIP_MEMORY_SCOPE_AGENT);
        __syncthreads();
        int idx = (int)slot[0];
        __syncthreads();
        {
            const int nsup = l ? BG1_SUPER : BG0_SUPER;
            if (idx >= 1152 + nsup) break;
            if (idx >= 128) { const int r = idx - 128;
                if (r < 2 * nsup) { if (r & 1) { conv_super_item(a, lds, l ? BG1_FIRST : BG0_FIRST, l ? BG1_END : BG0_END, r >> 1); continue; } idx = 128 + (r >> 1); }
                else idx = 128 + nsup + (r - 2 * nsup); }
        }
        if (idx < 640) {
            const bool lat = idx < 128; const int j = lat ? idx : idx - 128; const bool gdn = lat ? (j < 64) : (j < 256);
            const int jj = lat ? (j & 63) : (gdn ? j : j - 256); const int s = lat ? 16 + (jj >> 4) : (jj >> 4); const int rem = jj & 15;
            if (gdn) gdn_chunk_item(a, lds, l, s, rem >> 1, rem & 1); else hgrn_chunk_item(a, lds, l, s, rem >> 1, rem & 1);
        } else { const int j = idx - 640; gmlp_item(a, lds, l, j >> 3, j & 7); }
    }
}

__device__ __forceinline__ void phase_onorm(KArgs& a, int l) {
    const int tid = otid(), lane = tid & 63, wave = tid >> 6, gw = blockIdx.x * 8 + wave, NGW = gridDim.x * 8;
    const int sub = lane >> 4, l16 = lane & 15;
    for (int it0 = gw * 4 + sub; it0 < NTOK * 16; it0 += NGW * 8) {
        u32x4 w0[2], w1[2], gg[2]; f32x4 g0[2], g1[2]; size_t o[2]; int br[2]; bool ok[2];
#pragma unroll
        for (int u = 0; u < 2; ++u) { const int it = it0 + u * NGW * 4; ok[u] = it < NTOK * 16; const int itc = ok[u] ? it : it0;
            br[u] = itc & 1; const int rh = itc >> 1, r = rh >> 3, h = rh & 7;
            const bf16_t* OS = (const bf16_t*)(a.ws + (br[u] ? WS_OSG : WS_OSH)); o[u] = (size_t)r * 1024 + h * 128 + 8 * l16;
            w0[u] = *(const u32x4*)(OS + o[u]); w1[u] = *(const u32x4*)(OS + (size_t)NTOK * 1024 + o[u]);
            gg[u] = *(const u32x4*)((const bf16_t*)(a.ws + (br[u] ? WS_GGO : WS_HGO)) + o[u]);
            const float* gnp = a.in[br[u] ? 19 : 12] + l * 128 + 8 * l16; g0[u] = *(const f32x4*)gnp; g1[u] = *(const f32x4*)(gnp + 4); }
#pragma unroll
        for (int u = 0; u < 2; ++u) {
            float y[8] = {bf_lo(w0[u].x) + bf_lo(w1[u].x), bf_hi(w0[u].x) + bf_hi(w1[u].x), bf_lo(w0[u].y) + bf_lo(w1[u].y), bf_hi(w0[u].y) + bf_hi(w1[u].y),
                          bf_lo(w0[u].z) + bf_lo(w1[u].z), bf_hi(w0[u].z) + bf_hi(w1[u].z), bf_lo(w0[u].w) + bf_lo(w1[u].w), bf_hi(w0[u].w) + bf_hi(w1[u].w)};
            float ss = 0.f;
#pragma unroll
            for (int e = 0; e < 8; ++e) ss += y[e] * y[e];
            const float rstd = rsqrtf(red16(ss) * (1.0f / 128.0f) + EPS);
            u32x4 out;
            out.x = pk2(y[0] * rstd * g0[u].x * bf_lo(gg[u].x), y[1] * rstd * g0[u].y * bf_hi(gg[u].x)); out.y = pk2(y[2] * rstd * g0[u].z * bf_lo(gg[u].y), y[3] * rstd * g0[u].w * bf_hi(gg[u].y));
            out.z = pk2(y[4] * rstd * g1[u].x * bf_lo(gg[u].z), y[5] * rstd * g1[u].y * bf_hi(gg[u].z)); out.w = pk2(y[6] * rstd * g1[u].z * bf_lo(gg[u].w), y[7] * rstd * g1[u].w * bf_hi(gg[u].w));
            if (ok[u]) *(u32x4*)((bf16_t*)(a.ws + (br[u] ? WS_OC : WS_OA)) + o[u]) = out;
        }
    }
}

#define XB_TMO      128
#define XB_XCNT(j)  (256  + 64 * (j))
#define XB_XSUB(j)  (1280 + 64 * (j))
#define XB_XGEN(j)  (2304 + 64 * (j))
#define XB_TOP      3328
#define XB_TOPGEN   3392
#define XCD_BAR_WORDS 3456
#define XB_SPIN_CAP (1u << 18)

__device__ __forceinline__ unsigned xb_ld(unsigned* p)              { return __hip_atomic_load(p, __ATOMIC_RELAXED, __HIP_MEMORY_SCOPE_AGENT); }
__device__ __forceinline__ unsigned xb_add(unsigned* p, unsigned v) { return __hip_atomic_fetch_add(p, v, __ATOMIC_RELAXED, __HIP_MEMORY_SCOPE_AGENT); }
__device__ __forceinline__ unsigned xb_xcc_id() { return (unsigned)__builtin_amdgcn_s_getreg((3 << 11) | 20) & 0xFu; }
#define XB_SPIN(cond, bar) do { unsigned _sp = 0; while (cond) { __builtin_amdgcn_s_sleep(1); \
    if ((++_sp & 255u) == 0u) { if (xb_ld(&(bar)[XB_TMO])) break; if (_sp > XB_SPIN_CAP) { atomicAdd(&(bar)[XB_TMO], 1u); break; } } } } while (0)

struct XcdBarrier {
    unsigned* bar; unsigned x;
    volatile LAS unsigned* st;
};

__device__ __forceinline__ XcdBarrier xcd_barrier_post(unsigned* bar, volatile LAS unsigned* st) {
    XcdBarrier b; b.bar = bar; b.x = xb_xcc_id(); b.st = st;
    if (threadIdx.x == 0) (void)xb_add(&bar[XB_XCNT(b.x)], 1u);
    return b;
}
__device__ __forceinline__ void xcd_barrier_complete(unsigned* bar, unsigned x, unsigned& nloc, unsigned& nx) {
    const unsigned G = gridDim.x * gridDim.y * gridDim.z;
    unsigned sum, cnt, mine, sp = 0u;
    for (;;) {
        sum = 0u; cnt = 0u; mine = 0u;
#pragma unroll
        for (unsigned j = 0; j < 16; ++j) { const unsigned c = xb_ld(&bar[XB_XCNT(j)]); sum += c; cnt += (c > 0u) ? 1u : 0u; mine = (j == x) ? c : mine; }
        if (sum == G) break;
        __builtin_amdgcn_s_sleep(1);
        if ((++sp & 255u) == 0u) { if (xb_ld(&bar[XB_TMO])) break; if (sp > XB_SPIN_CAP) { atomicAdd(&bar[XB_TMO], 1u); break; } }
    }
    nloc = mine > 0u ? mine : 1u; nx = cnt > 0u ? cnt : 1u;
}

__device__ __forceinline__ void xcd_barrier(const XcdBarrier& b) {
    asm volatile("s_waitcnt vmcnt(0)" ::: "memory");
    __syncthreads();
    if (threadIdx.x == 0) {
        unsigned* bar = b.bar;
        __builtin_amdgcn_s_waitcnt(0);
        unsigned nloc = b.st[0], nx = b.st[1];
        if (nloc == 0u) { xcd_barrier_complete(bar, b.x, nloc, nx); b.st[0] = nloc; b.st[1] = nx; }
        const unsigned old = xb_add(&bar[XB_XSUB(b.x)], 1u);
        const unsigned gen = old / nloc;
        if (old + 1u == (gen + 1u) * nloc) {
            __builtin_amdgcn_fence(__ATOMIC_RELEASE, "agent");
            asm volatile("s_waitcnt vmcnt(0)" ::: "memory");
            const unsigned og = xb_add(&bar[XB_TOP], 1u);
            const unsigned tg = og / nx;
            if (og + 1u == (tg + 1u) * nx) xb_add(&bar[XB_TOPGEN], 1u);
            else XB_SPIN(xb_ld(&bar[XB_TOPGEN]) == tg, bar);
            __builtin_amdgcn_fence(__ATOMIC_ACQUIRE, "agent");
            xb_add(&bar[XB_XGEN(b.x)], 1u);
            asm volatile("s_waitcnt vmcnt(0)" ::: "memory");
        } else {
            XB_SPIN(xb_ld(&bar[XB_XGEN(b.x)]) == gen, bar);
            __builtin_amdgcn_fence(__ATOMIC_ACQUIRE, "agent");
            asm volatile("s_waitcnt vmcnt(0)" ::: "memory");
        }
    }
    __syncthreads();
}


__device__ __forceinline__ void run_phase(LAS unsigned char* lds, int ph, int rep) {
    KArgs& a = *get_args();
#ifndef DIAG_ONLY
    if (ph == 0) { phase_prologue(a, lds); return; }
    if (ph == 21) { phase_final_norm(a); return; }
#else
    if (ph == 0 || ph == 21) { if (DIAG_ONLY == 10) phase_prologue(a, lds); return; }
#endif
    const int l = (ph - 1) / 10, k = (ph - 1) % 10;
    unsigned char* wl = a.ws + WS_W + (size_t)l * W_LSTRIDE;
    const int G = gridDim.x, c = blockIdx.x;
#ifdef DIAG_ONLY
    if (k != DIAG_ONLY) return;
#endif
    switch (k) {
    case 0: phase_norm_mod(a, l, 0); break;
    case 1: { pg8::Gemm g{(const bf16_t*)(a.ws + WS_H), (const bf16_t*)(wl + W_IN), NTOK, IN_PAD, D}; pg8::StaticOrder S; S.init(NTOK, IN_PAD, G, c);
              EpiIn E{a.ws, a.in[11], a.in[17], a.in[18], l}; pg8::gemm_phase<EpiIn, pg8::StaticOrder, true, true>(lds, g, S, E); } break;
    case 2: phase_gdn_prep(a, l); break;
    case 3: phase_mixers(a, lds, l + 2 * rep); break;
    case 4: phase_onorm(a, l); break;
    case 5: { pg8::Gemm g{(const bf16_t*)(a.ws + WS_OA), (const bf16_t*)(wl + W_BR), 3 * NTOK, 3 * D, 1024};
              Br3Order S; S.base.init(NTOK, D, G, c); EpiBr3 E{a.ws}; pg8::gemm_phase<EpiBr3, Br3Order, true, true>(lds, g, S, E); } break;
    case 6: { pg8::Gemm g{(const bf16_t*)(a.ws + WS_MERGED), (const bf16_t*)(wl + W_OUT), NTOK, D, D}; pg8::StaticOrder S; S.init(NTOK, D, G, c);
              EpiRes E{a.ws, l, 4096}; pg8::gemm_phase<EpiRes, pg8::StaticOrder, true, true>(lds, g, S, E); } break;
    case 7: phase_norm_mod(a, l, 1); break;
    case 8: { pg8::Gemm g{(const bf16_t*)(a.ws + WS_H), (const bf16_t*)(wl + W_FF1), NTOK, DFF, D}; pg8::StaticOrder S; S.init(NTOK, DFF, G, c);
              EpiRelu2 E{a.ws}; pg8::gemm_phase<EpiRelu2, pg8::StaticOrder, true, true>(lds, g, S, E); } break;
    case 9: { pg8::Gemm g{(const bf16_t*)(a.ws + WS_FFH), (const bf16_t*)(wl + W_FF2), NTOK, D, DFF}; pg8::StaticOrder S; S.init(NTOK, D, G, c);
              EpiRes E{a.ws, l, 10240}; pg8::gemm_phase<EpiRes, pg8::StaticOrder, true, true>(lds, g, S, E); } break;
    }
}

#ifndef PROBE_REPEAT_K
#define PROBE_REPEAT_K (-1)
#endif
__global__ void __launch_bounds__(NTHR, 2) fwd_megakernel(Args args) {
    extern __shared__ __attribute__((aligned(16))) unsigned char lds_raw[];
    LAS unsigned char* lds = (LAS unsigned char*)lds_raw;
#if MK_MULTI
    for (int ph = args.ph_lo; ph < args.ph_hi; ++ph) { run_phase(lds, ph, 0); __syncthreads(); }
#else
    cg::grid_group grid = cg::this_grid();
    volatile LAS unsigned* misc = (volatile LAS unsigned*)(lds + LDS_MISC);
    if (threadIdx.x < 16) misc[threadIdx.x] = 0u;
    __syncthreads();
    XcdBarrier bar = xcd_barrier_post((unsigned*)(args.ws + WS_CTL) + CW_BAR, misc + 8);
    grid.sync();
#pragma unroll 1
    for (int ph = args.ph_lo; ph < args.ph_hi; ++ph) {
        run_phase(lds, ph, 0);
        if (PROBE_REPEAT_K != -1 && ((PROBE_REPEAT_K == -2 && ph == 0) || (ph >= 1 && ph <= 20 && (ph - 1) % 10 == PROBE_REPEAT_K))) { xcd_barrier(bar); run_phase(lds, ph, 1); }
        if (ph + 1 < args.ph_hi) {
            xcd_barrier(bar);
        }
    }
#endif
}

extern "C" void kernel_launch(void* const* d_in, const int* in_sizes, int n_in, void* d_out, int out_size, void* d_ws, size_t ws_size, hipStream_t stream) {
    static int grid = 0;
    if (grid == 0) {
        int dev = 0, cus = 0, per_cu = 0;
        if (n_in != 27 || ws_size < WS_END) { fprintf(stderr, "kernel_launch: unexpected n_in %d or ws_size %zu (< %zu)\n", n_in, ws_size, (size_t)WS_END); grid = -1; return; }
        if (hipGetDevice(&dev) != hipSuccess || hipDeviceGetAttribute(&cus, hipDeviceAttributeMultiprocessorCount, dev) != hipSuccess) { grid = -1; return; }
        if (hipFuncSetAttribute((const void*)fwd_megakernel, hipFuncAttributeMaxDynamicSharedMemorySize, LDS_BYTES) != hipSuccess) { fprintf(stderr, "kernel_launch: hipFuncSetAttribute failed\n"); grid = -1; return; }
        if (hipOccupancyMaxActiveBlocksPerMultiprocessor(&per_cu, (const void*)fwd_megakernel, NTHR, LDS_BYTES) != hipSuccess || per_cu < 1) { fprintf(stderr, "kernel_launch: occupancy query failed (%d)\n", per_cu); (void)hipGetLastError(); per_cu = 1; }
        grid = cus * per_cu;
    }
    if (grid < 0) return;
    (void)hipMemsetAsync((char*)d_ws + WS_CTL, 0, CTL_BYTES, stream);
    Args a{};
    for (int i = 0; i < 27; ++i) a.in[i] = (const float*)d_in[i];
    a.out = (float*)d_out; a.ws = (unsigned char*)d_ws;
#if MK_MULTI
    for (int ph = 0; ph < N_PHASES; ++ph) { a.ph_lo = ph; a.ph_hi = ph + 1; hipLaunchKernelGGL(fwd_megakernel, dim3(grid), dim3(NTHR), LDS_BYTES, stream, a); }
#else
    a.ph_lo = 0; a.ph_hi = N_PHASES;
    void* kargs[] = {(void*)&a};
    hipError_t e = hipLaunchCooperativeKernel((const void*)fwd_megakernel, dim3(grid), dim3(NTHR), kargs, LDS_BYTES, stream);
    if (e != hipSuccess) fprintf(stderr, "kernel_launch: cooperative launch failed: %s (grid %d)\n", hipGetErrorString(e), grid);
#endif
}
```

```cpp
#include <hip/hip_runtime.h>
#include <hip/hip_cooperative_groups.h>
#include <cstdio>
#include <cstdint>
namespace cg = cooperative_groups;
namespace pg8 {
#define PG8_LAS __attribute__((address_space(3)))
typedef unsigned short bf16_t;
typedef short bf16x8 __attribute__((ext_vector_type(8)));
typedef float f32x4 __attribute__((ext_vector_type(4)));
typedef unsigned u32x4 __attribute__((ext_vector_type(4)));
constexpr int BM = 256, BK = 64, HALF = 128, HTB = HALF * BK * 2  , STAGE_BYTES = 8 * HTB, NXCD = 8, WGM = 8;

__host__ __device__ __forceinline__ int lds_byte(int r, int c) { const int st = (r >> 4) * 2 + (c >> 5), rr = r & 15, cc = c & 31, ob = rr * 64 + cc * 2; return st * 1024 + (ob ^ (((ob >> 9) & 1) << 5)); }
__host__ __device__ __forceinline__ void stage_rc(int b, int& R, int& C) { const int st = b / 1024, sb = b % 1024, swz = sb ^ (((sb >> 9) & 1) << 5); R = (st >> 1) * 16 + swz / 64; C = (st & 1) * 32 + (swz % 64) / 2; }
__host__ __device__ __forceinline__ int perm32(int rho) { const int n = rho >> 4, i = rho & 15; return 8 * (i >> 2) + 4 * n + (i & 3); }

struct Unit { int pm, pn; };
struct Gemm { const bf16_t* A; const bf16_t* Bt; int M, N, K; };

struct StaticOrder {
    int nM, nN, nwg, G, c;
    __host__ __device__ void init(int M, int N, int G_, int c_) { nM = M / BM; nN = N / BM; nwg = nM * nN; G = G_; c = c_; }
    __host__ __device__ bool next(int i, Unit& u) const {
        const long L = (long)i * G + c; if (L >= nwg) return false;
        int wgid = (int)L; { const int q = nwg / NXCD, r = nwg % NXCD, xcd = wgid % NXCD, off = wgid / NXCD; wgid = (xcd < r ? xcd * (q + 1) : r * (q + 1) + (xcd - r) * q) + off; }
        const int nig = WGM * nN, gid = wgid / nig, fm = gid * WGM, gsz = (nM - fm) < WGM ? (nM - fm) : WGM;
        u.pm = fm + ((wgid % nig) % gsz); u.pn = (wgid % nig) / gsz; return true;
    }
    __device__ __forceinline__ void a_ready(const Unit&) const {}
    __device__ __forceinline__ void done(const Unit&) const {}
};

__device__ __forceinline__ unsigned cvt_pk_bf16(float lo, float hi) { unsigned r; asm volatile("v_cvt_pk_bf16_f32 %0, %1, %2" : "=v"(r) : "v"(lo), "v"(hi)); return r; }
template <class Epi, class Sched, bool ALIGN_EPI = false, bool SP2 = false>
__device__ __forceinline__ void gemm_phase(PG8_LAS unsigned char* lds, const Gemm g, const Sched& S, const Epi& E) {
    int tid_o = threadIdx.x; asm volatile("" : "+v"(tid_o)); const int tid = tid_o, wid = __builtin_amdgcn_readfirstlane(tid >> 6), lane = tid & 63, wr = wid >> 2, wc = wid & 3, fr = lane & 15, fq = lane >> 4;
    const int K = g.K, nt = K / BK;
    unsigned voffA[2], voffB[2];
#pragma unroll
    for (int i = 0; i < 2; ++i) { int R, C; stage_rc(tid * 16 + i * 8192, R, C); const int Rb = Epi::PERM ? ((R & ~31) + perm32(R & 31)) : R;
        voffA[i] = (unsigned)(R * K + C) * 2u; voffB[i] = (unsigned)(Rb * K + C) * 2u; }
    const size_t kstep = (size_t)(BK * 2);
    const size_t hstep = (size_t)HALF * K * 2;
    const size_t tstep = 2 * hstep;
    const unsigned ldsw = (unsigned)wid * 1024u;
    const int aoff = lds_byte(wr * 64 + fr, fq * 8), boff = lds_byte(wc * 32 + fr, fq * 8);
#define PG8_SA(b, h) (((b) * 2 + (h)) * HTB)
#define PG8_SB(b, h) ((4 + (b) * 2 + (h)) * HTB)
#define PG8_STAGE(bufoff, gbase, voff) do { _Pragma("unroll") for (int _i = 0; _i < 2; ++_i) \
        __builtin_amdgcn_global_load_lds((const unsigned*)((const char*)(gbase) + (voff)[_i]), (PG8_LAS unsigned*)(lds + (bufoff) + ldsw + _i * 8192), 16, 0, 0); } while (0)
#define PG8_LDA(dst, b, h) do { _Pragma("unroll") for (int m = 0; m < 4; ++m) _Pragma("unroll") for (int k = 0; k < 2; ++k) dst[m][k] = *(const PG8_LAS bf16x8*)(lds + PG8_SA(b, h) + aoff + m * 2048 + k * 1024); } while (0)
#define PG8_LDB(dst, b, h) do { _Pragma("unroll") for (int n = 0; n < 2; ++n) _Pragma("unroll") for (int k = 0; k < 2; ++k) dst[n][k] = *(const PG8_LAS bf16x8*)(lds + PG8_SB(b, h) + boff + n * 2048 + k * 1024); } while (0)
#define PG8_MMA(ai, bj, At, Bt) do { __builtin_amdgcn_s_setprio(1); _Pragma("unroll") for (int m = 0; m < 4; ++m) _Pragma("unroll") for (int n = 0; n < 2; ++n) _Pragma("unroll") for (int k = 0; k < 2; ++k) \
        acc[ai][bj][m][n] = __builtin_amdgcn_mfma_f32_16x16x32_bf16(Bt[n][k], At[m][k], acc[ai][bj][m][n], 0, 0, 0); __builtin_amdgcn_s_setprio(0); } while (0)
#define PG8_WAIT_V(n) asm volatile("s_waitcnt vmcnt(" #n ")" ::: "memory")
#define PG8_WAIT_L(n) asm volatile("s_waitcnt lgkmcnt(" #n ")" ::: "memory")
#define PG8_BAR __builtin_amdgcn_s_barrier()
#define PG8_SCHED __builtin_amdgcn_sched_barrier(0)
    Unit cur, nxt; int ui = 0;
    if (!S.next(0, cur)) return;
    f32x4 acc[2][2][4][2];
#pragma unroll
    for (int a = 0; a < 2; ++a)
#pragma unroll
        for (int b = 0; b < 2; ++b)
#pragma unroll
            for (int m = 0; m < 4; ++m)
#pragma unroll
                for (int n = 0; n < 2; ++n) acc[a][b][m][n] = (f32x4){0.f, 0.f, 0.f, 0.f};
    bf16x8 At[4][2], B0[2][2], B1[2][2];
    const char* cA = (const char*)g.A + (size_t)cur.pm * tstep; const char* cB = (const char*)g.Bt + (size_t)cur.pn * tstep;
    S.a_ready(cur);
    if constexpr (SP2) {
        PG8_STAGE(PG8_SB(0, 0), cB, voffB); PG8_STAGE(PG8_SB(0, 1), cB + hstep, voffB); PG8_STAGE(PG8_SA(0, 0), cA, voffA); PG8_STAGE(PG8_SA(0, 1), cA + hstep, voffA);
        if (wr == 1) PG8_BAR;
        PG8_WAIT_V(2); PG8_BAR;
        PG8_STAGE(PG8_SB(1, 0), cB + kstep, voffB); PG8_STAGE(PG8_SA(1, 0), cA + kstep, voffA); PG8_STAGE(PG8_SB(1, 1), cB + hstep + kstep, voffB);
        PG8_WAIT_V(6); PG8_BAR;
    } else {
        PG8_STAGE(PG8_SB(0, 0), cB, voffB); PG8_STAGE(PG8_SA(0, 0), cA, voffA); PG8_STAGE(PG8_SB(0, 1), cB + hstep, voffB); PG8_STAGE(PG8_SA(0, 1), cA + hstep, voffA);
        if (wr == 1) PG8_BAR;
        PG8_WAIT_V(4); PG8_BAR;
        PG8_STAGE(PG8_SB(1, 0), cB + kstep, voffB); PG8_STAGE(PG8_SA(1, 0), cA + kstep, voffA); PG8_STAGE(PG8_SB(1, 1), cB + hstep + kstep, voffB);
        PG8_WAIT_V(6); PG8_BAR;
    }
    for (;;) {
        const bool has_next = S.next(ui + 1, nxt);
        const char* nA = has_next ? (const char*)g.A + (size_t)nxt.pm * tstep : cA; const char* nB = has_next ? (const char*)g.Bt + (size_t)nxt.pn * tstep : cB;
        for (int t = 0; t < nt; t += 2) {
            const bool last = (t == nt - 2);
            const char* a1 = cA + (size_t)(t + 1) * kstep;
            const char* a2 = last ? nA : cA + (size_t)(t + 2) * kstep; const char* b2 = last ? nB : cB + (size_t)(t + 2) * kstep;
            const char* a3 = a2 + kstep; const char* b3 = b2 + kstep;
            if (last && has_next) S.a_ready(nxt);
            if constexpr (SP2) {
            PG8_LDB(B0, 0, 0); PG8_LDB(B1, 0, 1); PG8_SCHED; PG8_LDA(At, 0, 0); PG8_STAGE(PG8_SA(1, 1), a1 + hstep, voffA);
            PG8_WAIT_V(8); PG8_WAIT_L(0); PG8_BAR; PG8_MMA(0, 0, At, B0); PG8_MMA(0, 1, At, B1); PG8_BAR; PG8_SCHED;
            PG8_LDA(At, 0, 1); PG8_STAGE(PG8_SB(0, 0), b2, voffB); PG8_STAGE(PG8_SB(0, 1), b2 + hstep, voffB); PG8_STAGE(PG8_SA(0, 0), a2, voffA);
            PG8_WAIT_V(8); PG8_WAIT_L(0); PG8_BAR; PG8_MMA(1, 0, At, B0); PG8_MMA(1, 1, At, B1); PG8_BAR; PG8_SCHED;
            PG8_LDB(B0, 1, 0); PG8_LDB(B1, 1, 1); PG8_SCHED; PG8_LDA(At, 1, 0); PG8_STAGE(PG8_SA(0, 1), a2 + hstep, voffA);
            PG8_WAIT_V(8); PG8_WAIT_L(0); PG8_BAR; PG8_MMA(0, 0, At, B0); PG8_MMA(0, 1, At, B1); PG8_BAR; PG8_SCHED;
            PG8_LDA(At, 1, 1); PG8_STAGE(PG8_SB(1, 0), b3, voffB); PG8_STAGE(PG8_SB(1, 1), b3 + hstep, voffB); PG8_STAGE(PG8_SA(1, 0), a3, voffA);
            PG8_WAIT_V(8); PG8_WAIT_L(0); PG8_BAR; PG8_MMA(1, 0, At, B0); PG8_MMA(1, 1, At, B1); PG8_BAR; PG8_SCHED;
            } else {
            PG8_LDB(B0, 0, 0); PG8_SCHED; PG8_LDA(At, 0, 0); PG8_STAGE(PG8_SA(1, 1), a1 + hstep, voffA);
            PG8_WAIT_L(8); PG8_BAR; PG8_WAIT_L(0); PG8_MMA(0, 0, At, B0); PG8_BAR; PG8_SCHED;
            PG8_LDB(B1, 0, 1); PG8_STAGE(PG8_SB(0, 0), b2, voffB);
            PG8_BAR; PG8_WAIT_L(0); PG8_MMA(0, 1, At, B1); PG8_BAR;
            PG8_LDA(At, 0, 1); PG8_STAGE(PG8_SA(0, 0), a2, voffA);
            PG8_BAR; PG8_WAIT_L(0); PG8_MMA(1, 0, At, B0); PG8_BAR; PG8_SCHED;
            PG8_STAGE(PG8_SB(0, 1), b2 + hstep, voffB);
            PG8_WAIT_V(6); PG8_BAR; PG8_MMA(1, 1, At, B1); PG8_BAR;
            PG8_LDB(B0, 1, 0); PG8_SCHED; PG8_LDA(At, 1, 0); PG8_STAGE(PG8_SA(0, 1), a2 + hstep, voffA);
            PG8_WAIT_L(8); PG8_BAR; PG8_WAIT_L(0); PG8_MMA(0, 0, At, B0); PG8_BAR; PG8_SCHED;
            PG8_LDB(B1, 1, 1); PG8_STAGE(PG8_SB(1, 0), b3, voffB);
            PG8_BAR; PG8_WAIT_L(0); PG8_MMA(0, 1, At, B1); PG8_BAR;
            PG8_LDA(At, 1, 1); PG8_STAGE(PG8_SA(1, 0), a3, voffA);
            PG8_BAR; PG8_WAIT_L(0); PG8_MMA(1, 0, At, B0); PG8_BAR; PG8_SCHED;
            PG8_STAGE(PG8_SB(1, 1), b3 + hstep, voffB);
            PG8_WAIT_V(6); PG8_BAR; PG8_MMA(1, 1, At, B1); PG8_BAR;
            }
        }
        if constexpr (ALIGN_EPI) { if (wr == 0) PG8_BAR; }
        bool keep_acc = false;
        if constexpr (!Epi::AFTER_DRAIN) { E(acc, cur, wr, wc, fr, fq); if constexpr (Epi::KEEP) keep_acc = E.keep(cur); S.done(cur); }
        if (!has_next) break;
        if (!keep_acc)
#pragma unroll
        for (int a = 0; a < 2; ++a)
#pragma unroll
            for (int b = 0; b < 2; ++b)
#pragma unroll
                for (int m = 0; m < 4; ++m)
#pragma unroll
                    for (int n = 0; n < 2; ++n) acc[a][b][m][n] = (f32x4){0.f, 0.f, 0.f, 0.f};
        cur = nxt; cA = nA; cB = nB; ++ui;
        if constexpr (ALIGN_EPI) { if (wr == 1) PG8_BAR; }
    }
    PG8_WAIT_V(0);
    if constexpr (!ALIGN_EPI) { if (wr == 0) PG8_BAR; }
    PG8_BAR;
    if constexpr (Epi::AFTER_DRAIN) { E.fused(acc, cur, wr, wc, fr, fq, lds, wid, lane); S.done(cur); }
#undef PG8_SA
#undef PG8_SB
#undef PG8_STAGE
#undef PG8_LDA
#undef PG8_LDB
#undef PG8_MMA
#undef PG8_WAIT_V
#undef PG8_WAIT_L
#undef PG8_BAR
#undef PG8_SCHED
}
}


#ifndef MK_MULTI
#define MK_MULTI 0
#endif
#define LAS __attribute__((address_space(3)))
typedef unsigned short bf16_t;
typedef float f32x4 __attribute__((ext_vector_type(4)));
typedef float f32x2 __attribute__((ext_vector_type(2)));
typedef unsigned u32x4 __attribute__((ext_vector_type(4)));
typedef unsigned u32x2 __attribute__((ext_vector_type(2)));
typedef short bf16x8 __attribute__((ext_vector_type(8)));

constexpr int D = 2048, NTOK = 8192, NCTX = 4096, IN_DIM = 17440, IN_PAD = 17664, DFF = 8192;
constexpr int NTHR = 512;
constexpr float EPS = 1e-6f;
constexpr size_t MiB = 1u << 20;
constexpr size_t WS_CTL = 0, CTL_BYTES = 1 * MiB;
constexpr size_t WS_MOD = 1 * MiB;
constexpr size_t WS_W = 2 * MiB, W_LSTRIDE = 153 * MiB;
constexpr size_t W_IN = 0, W_BR = 69 * MiB, W_OUT = 81 * MiB, W_FF1 = 89 * MiB, W_FF2 = 121 * MiB;
constexpr size_t WS_X = 308 * MiB;
constexpr size_t WS_H = 372 * MiB;
constexpr size_t WS_FF = 404 * MiB, WS_FB = 436 * MiB;
constexpr size_t WS_HQ = 468 * MiB, WS_HI = 484 * MiB, WS_HGO = 500 * MiB, WS_CU = 516 * MiB, WS_CV = 532 * MiB;
constexpr size_t WS_GQKV = 548 * MiB;
constexpr size_t WS_GGO = 596 * MiB;
constexpr size_t WS_GATES = 612 * MiB;
constexpr size_t WS_GAB = 708 * MiB;
constexpr size_t WS_GQ = 709 * MiB, WS_GK = 741 * MiB, WS_GV = 773 * MiB;
constexpr size_t WS_OA = 805 * MiB, WS_OB = 821 * MiB, WS_OC = 837 * MiB;
constexpr size_t WS_END = 853 * MiB;
constexpr size_t WS_OSH = WS_H;
constexpr size_t WS_OSG = WS_GQKV;
constexpr size_t WS_FFH = WS_FF;
constexpr size_t WS_MERGED = WS_GV;
constexpr int CW_QUEUE = 64;
constexpr int CW_BAR = 4096;
constexpr int LDS_MISC = 132096, LDS_BYTES = 132096 + 512;
constexpr size_t OUT_Y = 0, OUT_SHG = (size_t)NTOK * D, OUT_SGDN = OUT_SHG + (size_t)16 * 2 * 2 * 8 * 16384;
constexpr int N_PHASES = 22;

__device__ __forceinline__ int otid() { int t = threadIdx.x; asm volatile("" : "+v"(t)); return t; }
__device__ __forceinline__ int obid() { int t = blockIdx.x; asm volatile("" : "+s"(t)); return t; }
struct Args { const float* in[27]; float* out; unsigned char* ws; int ph_lo, ph_hi; };
typedef const Args __attribute__((address_space(4))) KArgs;
__device__ __forceinline__ KArgs* get_args() { KArgs* p = (KArgs*)__builtin_amdgcn_kernarg_segment_ptr(); asm volatile("" : "+s"(p)); return p; }

__device__ __forceinline__ unsigned f2bf(float f) { unsigned u = __builtin_bit_cast(unsigned, f); return (u + 0x7fffu + ((u >> 16) & 1u)) >> 16; }
typedef __bf16 bf16x2_nat __attribute__((ext_vector_type(2)));
__device__ __forceinline__ unsigned pk2(float lo, float hi) { const f32x2 v = {lo, hi}; return __builtin_bit_cast(unsigned, __builtin_convertvector(v, bf16x2_nat)); }
__device__ __forceinline__ float bf_lo(unsigned w) { return __builtin_bit_cast(float, w << 16); }
__device__ __forceinline__ float bf_hi(unsigned w) { return __builtin_bit_cast(float, w & 0xffff0000u); }
__device__ __forceinline__ float wave_sum(float v) {
#pragma unroll
    for (int o = 1; o < 64; o <<= 1) v += __shfl_xor(v, o);
    return v;
}
__device__ __forceinline__ float sigmoidf_(float x) { return __builtin_amdgcn_rcpf(1.0f + __expf(-x)); }
__device__ __forceinline__ float siluf_(float x) { return x * __builtin_amdgcn_rcpf(1.0f + __expf(-x)); }
__device__ __forceinline__ float geluf_(float x) { return 0.5f * x * (1.0f + erff(x * 0.70710678118f)); }
#define LDS_BARRIER() do { asm volatile("s_waitcnt lgkmcnt(0)" ::: "memory"); __builtin_amdgcn_s_barrier(); asm volatile("" ::: "memory"); } while (0)
__device__ __forceinline__ float red16(float x) {
    int t;
    t = __builtin_amdgcn_update_dpp(0, __builtin_bit_cast(int, x), 0xB1, 0xF, 0xF, false); x += __builtin_bit_cast(float, t);
    t = __builtin_amdgcn_update_dpp(0, __builtin_bit_cast(int, x), 0x4E, 0xF, 0xF, false); x += __builtin_bit_cast(float, t);
    t = __builtin_amdgcn_update_dpp(0, __builtin_bit_cast(int, x), 0x141, 0xF, 0xF, false); x += __builtin_bit_cast(float, t);
    t = __builtin_amdgcn_update_dpp(0, __builtin_bit_cast(int, x), 0x140, 0xF, 0xF, false); x += __builtin_bit_cast(float, t);
    return x;
}
struct TItem { const float* p; bf16_t* q; int N, K; };
constexpr int TI_IN = 32 * 545, TI_BR = 16 * 64, TI_OUT = 32 * 64, TI_F1 = 32 * 256, TI_F2 = 128 * 64, TI_L = TI_IN + 3 * TI_BR + TI_OUT + TI_F1 + TI_F2;
__device__ __forceinline__ void titem_decode(KArgs& a, int it, int lane, TItem& t) {
    const int l = it / TI_L; int r = it - l * TI_L;
    unsigned char* wl = a.ws + WS_W + (size_t)l * W_LSTRIDE;
    const float* W; bf16_t* WT; int K, N; bool remap = false;
    if (r < TI_IN) { W = a.in[10] + (size_t)l * 2048 * IN_DIM; K = 2048; N = IN_DIM; WT = (bf16_t*)(wl + W_IN); remap = true; }
    else if ((r -= TI_IN) < TI_BR) { W = a.in[20] + (size_t)l * 1024 * 2048; K = 1024; N = 2048; WT = (bf16_t*)(wl + W_BR); }
    else if ((r -= TI_BR) < TI_BR) { W = a.in[21] + (size_t)l * 1024 * 2048; K = 1024; N = 2048; WT = (bf16_t*)(wl + W_BR + 4 * MiB); }
    else if ((r -= TI_BR) < TI_BR) { W = a.in[22] + (size_t)l * 1024 * 2048; K = 1024; N = 2048; WT = (bf16_t*)(wl + W_BR + 8 * MiB); }
    else if ((r -= TI_BR) < TI_OUT) { W = a.in[23] + (size_t)l * 2048 * 2048; K = 2048; N = 2048; WT = (bf16_t*)(wl + W_OUT); }
    else if ((r -= TI_OUT) < TI_F1) { W = a.in[24] + (size_t)l * 2048 * 8192; K = 2048; N = 8192; WT = (bf16_t*)(wl + W_FF1); }
    else { r -= TI_F1; W = a.in[25] + (size_t)l * 8192 * 2048; K = 8192; N = 2048; WT = (bf16_t*)(wl + W_FF2); }
    const int nblk = N / 32, kb = r / nblk, nb = r - kb * nblk, k0 = 64 * kb, n0 = 32 * nb;
    int drow0 = n0;
    if (remap) drow0 = (n0 < 11264) ? n0 : ((n0 < 11296) ? 17408 : n0 - 32);
    t.p = W + (size_t)(k0 + (lane >> 3)) * N + n0 + 4 * (lane & 7); t.N = N; t.K = K;
    t.q = WT + (size_t)(drow0 + (lane >> 3)) * K + k0 + 8 * (lane & 7);
}
__device__ __forceinline__ void titem_load(const TItem& t, f32x4 (&v)[8]) {
#pragma unroll
    for (int i = 0; i < 8; ++i) v[i] = __builtin_nontemporal_load((const f32x4*)(t.p + (size_t)(8 * i) * t.N));
}
__device__ __forceinline__ void titem_store(const TItem& t, const f32x4 (&v)[8], LAS float* scr, int lane) {
    const int kr = lane >> 3, n4 = 4 * (lane & 7);
#pragma unroll
    for (int i = 0; i < 8; ++i) { LAS float* d = scr + (kr + 8 * i) * 33 + n4; d[0] = v[i].x; d[1] = v[i].y; d[2] = v[i].z; d[3] = v[i].w; }
    asm volatile("s_waitcnt lgkmcnt(0)" ::: "memory");
    const int c = lane & 7;
#pragma unroll
    for (int j = 0; j < 4; ++j) { const int n = (lane >> 3) + 8 * j; const LAS float* s = scr + (8 * c) * 33 + n;
        u32x4 o; o.x = pk2(s[0 * 33], s[1 * 33]); o.y = pk2(s[2 * 33], s[3 * 33]); o.z = pk2(s[4 * 33], s[5 * 33]); o.w = pk2(s[6 * 33], s[7 * 33]);
        *(u32x4*)(t.q + (size_t)(8 * j) * t.K) = o; }
    asm volatile("s_waitcnt lgkmcnt(0)" ::: "memory");
}

__device__ __forceinline__ void titem_range(KArgs& a, LAS float* scr, int lane, int it0, int tot, int step) {
    TItem ta, tb; f32x4 va[8], vb[8];
    int it = it0;
    if (it < tot) { titem_decode(a, it, lane, ta); titem_load(ta, va); }
    for (;;) {
        if (it >= tot) break;
        if (it + step < tot) { titem_decode(a, it + step, lane, tb); titem_load(tb, vb); }
        titem_store(ta, va, scr, lane);
        it += step;
        if (it >= tot) break;
        if (it + step < tot) { titem_decode(a, it + step, lane, ta); titem_load(ta, va); }
        titem_store(tb, vb, scr, lane);
        it += step;
    }
}
constexpr int BG_PER = 64;
constexpr int BG0_FIRST = TI_IN, BG0_END = TI_L + TI_IN, BG0_SUPER = (BG0_END - BG0_FIRST + BG_PER - 1) / BG_PER;
constexpr int BG1_FIRST = TI_L + TI_IN, BG1_END = 2 * TI_L, BG1_SUPER = (BG1_END - BG1_FIRST + BG_PER - 1) / BG_PER;
__device__ __forceinline__ void conv_super_item(KArgs& a, LAS unsigned char* lds, int first, int last, int sidx) {
    const int tid = otid(), lane = tid & 63, wave = tid >> 6;
    const int base = first + BG_PER * sidx, end = (base + BG_PER < last) ? base + BG_PER : last;
    titem_range(a, (LAS float*)(lds + wave * 16384), lane, base + wave, end, 8);
    __syncthreads();
}

__device__ __forceinline__ void phase_prologue(KArgs& a, LAS unsigned char* lds) {
    const int tid = otid(), lane = tid & 63, wave = tid >> 6, G = gridDim.x;
    float* MOD = (float*)(a.ws + WS_MOD);
    LAS float* sc = (LAS float*)lds;
    LAS float* red = (LAS float*)(lds + 40960);
    for (int i = tid; i < 5 * 2048; i += NTHR) { const int v = i >> 11, k = i & 2047; const float x = (v == 0) ? a.in[5][k] : a.in[2][(v - 1) * 2048 + k]; sc[i] = siluf_(x); }
    __syncthreads();
    for (int chunk = blockIdx.x; chunk < 256; chunk += G) {
        const int l = chunk >> 7, n0 = (chunk & 127) * 96;
        if (tid < 384) {
            const int kg = tid / 24, ln = tid % 24;
            const float* W = a.in[8] + ((size_t)l * 2048 + kg * 128) * 12288 + n0 + 4 * ln;
            f32x4 acc[5];
#pragma unroll
            for (int v = 0; v < 5; ++v) acc[v] = (f32x4){0.f, 0.f, 0.f, 0.f};
#pragma unroll 16
            for (int k = 0; k < 128; ++k) {
                const f32x4 w = __builtin_nontemporal_load((const f32x4*)(W + (size_t)k * 12288));
#pragma unroll
                for (int v = 0; v < 5; ++v) { const float s = sc[v * 2048 + kg * 128 + k]; acc[v] += s * w; }
            }
#pragma unroll
            for (int v = 0; v < 5; ++v) *(LAS f32x4*)(red + (kg * 5 + v) * 96 + 4 * ln) = acc[v];
        }
        __syncthreads();
        if (tid < 480) { const int v = tid / 96, c = tid % 96; float s = 0.f;
#pragma unroll
            for (int kg = 0; kg < 16; ++kg) s += red[(kg * 5 + v) * 96 + c];
            MOD[(l * 5 + v) * 12288 + n0 + c] = s + a.in[9][l * 12288 + n0 + c]; }
        __syncthreads();
    }
    LAS float* scr = (LAS float*)(lds + wave * 16384);
    const int gw = blockIdx.x * 8 + wave, NGW = G * 8;
    titem_range(a, scr, lane, gw, TI_IN, NGW);
    for (int i = blockIdx.x * NTHR + tid; i < 2 * 57344; i += G * NTHR) { const int l = i / 57344, j = i - l * 57344;
        *(u32x4*)(a.ws + WS_W + (size_t)l * W_LSTRIDE + W_IN + (size_t)IN_DIM * 4096 + (size_t)j * 16) = (u32x4){0u, 0u, 0u, 0u}; }
}

__device__ __forceinline__ int mod_vec_of_row(int r) { return r < NCTX ? 0 : 1 + ((r - NCTX) >> 10); }

__device__ __forceinline__ void load_row8(const float* srcf, const bf16_t* srcb, int lane, float (&v)[4][8]) {
#pragma unroll
    for (int j = 0; j < 4; ++j) { const int c = 8 * (64 * j + lane);
        if (srcf) { const f32x4 x0 = *(const f32x4*)(srcf + c), x1 = *(const f32x4*)(srcf + c + 4);
            v[j][0] = x0.x; v[j][1] = x0.y; v[j][2] = x0.z; v[j][3] = x0.w; v[j][4] = x1.x; v[j][5] = x1.y; v[j][6] = x1.z; v[j][7] = x1.w; }
        else { const u32x4 p = *(const u32x4*)(srcb + c);
            v[j][0] = bf_lo(p.x); v[j][1] = bf_hi(p.x); v[j][2] = bf_lo(p.y); v[j][3] = bf_hi(p.y); v[j][4] = bf_lo(p.z); v[j][5] = bf_hi(p.z); v[j][6] = bf_lo(p.w); v[j][7] = bf_hi(p.w); } }
}
__device__ __forceinline__ void phase_norm_mod(KArgs& a, int l, int which) {
    const int tid = otid(), lane = tid & 63, wave = tid >> 6, gw = blockIdx.x * 8 + wave, NGW = gridDim.x * 8;
    bf16_t* X = (bf16_t*)(a.ws + WS_X); bf16_t* H = (bf16_t*)(a.ws + WS_H); const float* MOD = (const float*)(a.ws + WS_MOD);
    const bool first = (which == 0 && l == 0);
    const float* gvec = (which ? a.in[7] : a.in[6]) + l * 2048;
    for (int r0 = gw; r0 < NTOK; r0 += 2 * NGW) {
        float v[2][4][8];
#pragma unroll
        for (int u = 0; u < 2; ++u) { const int r = r0 + u * NGW;
            if (r < NTOK) load_row8(first ? (r < NCTX ? a.in[0] + (size_t)r * D : a.in[1] + (size_t)(r - NCTX) * D) : nullptr, X + (size_t)r * D, lane, v[u]); }
#pragma unroll
        for (int u = 0; u < 2; ++u) { const int r = r0 + u * NGW;
            if (r < NTOK) { float ss = 0.f;
#pragma unroll
                for (int j = 0; j < 4; ++j)
#pragma unroll
                    for (int e = 0; e < 8; ++e) ss += v[u][j][e] * v[u][j][e];
                const float rstd = rsqrtf(wave_sum(ss) * (1.0f / D) + EPS);
                const float* mod = MOD + (size_t)(l * 5 + mod_vec_of_row(r)) * 12288 + (which ? 6144 : 0);
#pragma unroll
                for (int j = 0; j < 4; ++j) { const int c = 8 * (64 * j + lane); float y[8];
#pragma unroll
                    for (int hf = 0; hf < 2; ++hf) { const f32x4 gv = *(const f32x4*)(gvec + c + 4 * hf), sh = *(const f32x4*)(mod + c + 4 * hf), scl = *(const f32x4*)(mod + 2048 + c + 4 * hf);
                        y[4 * hf] = v[u][j][4 * hf] * rstd * gv.x * (1.0f + scl.x) + sh.x; y[4 * hf + 1] = v[u][j][4 * hf + 1] * rstd * gv.y * (1.0f + scl.y) + sh.y;
                        y[4 * hf + 2] = v[u][j][4 * hf + 2] * rstd * gv.z * (1.0f + scl.z) + sh.z; y[4 * hf + 3] = v[u][j][4 * hf + 3] * rstd * gv.w * (1.0f + scl.w) + sh.w; }
                    u32x4 o; o.x = pk2(y[0], y[1]); o.y = pk2(y[2], y[3]); o.z = pk2(y[4], y[5]); o.w = pk2(y[6], y[7]);
                    *(u32x4*)(H + (size_t)r * D + c) = o;
                    if (first) { u32x4 xo; xo.x = pk2(v[u][j][0], v[u][j][1]); xo.y = pk2(v[u][j][2], v[u][j][3]); xo.z = pk2(v[u][j][4], v[u][j][5]); xo.w = pk2(v[u][j][6], v[u][j][7]); *(u32x4*)(X + (size_t)r * D + c) = xo; } } } }
    }
}
__device__ __forceinline__ void phase_final_norm(KArgs& a) {
    const int tid = otid(), lane = tid & 63, wave = tid >> 6, gw = blockIdx.x * 8 + wave, NGW = gridDim.x * 8;
    const bf16_t* X = (const bf16_t*)(a.ws + WS_X);
    for (int r = gw; r < NTOK; r += NGW) {
        float v[4][8]; load_row8(nullptr, X + (size_t)r * D, lane, v);
        float ss = 0.f;
#pragma unroll
        for (int j = 0; j < 4; ++j)
#pragma unroll
            for (int e = 0; e < 8; ++e) ss += v[j][e] * v[j][e];
        const float rstd = rsqrtf(wave_sum(ss) * (1.0f / D) + EPS);
#pragma unroll
        for (int j = 0; j < 4; ++j) { const int c = 8 * (64 * j + lane);
            const f32x4 g0 = *(const f32x4*)(a.in[26] + c), g1 = *(const f32x4*)(a.in[26] + c + 4);
            float* o = a.out + OUT_Y + (size_t)r * D + c;
            *(f32x4*)o = (f32x4){v[j][0] * rstd * g0.x, v[j][1] * rstd * g0.y, v[j][2] * rstd * g0.z, v[j][3] * rstd * g0.w};
            *(f32x4*)(o + 4) = (f32x4){v[j][4] * rstd * g1.x, v[j][5] * rstd * g1.y, v[j][6] * rstd * g1.z, v[j][7] * rstd * g1.w}; }
    }
}

enum { M_ID = 0, M_SILU = 1, M_GELU = 2, M_SIG = 3, M_FG = 4 };
__device__ __forceinline__ float gelu_as(float v) {
    const float av = fabsf(v), t = __builtin_amdgcn_rcpf(fmaf(av, 0.2316418882f, 1.0f));
    float q = fmaf(t, 0.5307027145f, -0.7265760135f); q = fmaf(q, t, 0.7107068705f); q = fmaf(q, t, -0.142248368f); q = fmaf(q, t, 0.127414796f); q = q * t;
    const float e = __builtin_amdgcn_exp2f(v * v * (-0.72134752044f));
    const float mm = v * (q * e);
    return v < 0.f ? mm : v - mm;
}
__device__ __forceinline__ f32x4 act4(f32x4 x, int mode, f32x4 lb) {
    f32x4 r = x;
    if (mode == M_SILU) { r.x = siluf_(x.x); r.y = siluf_(x.y); r.z = siluf_(x.z); r.w = siluf_(x.w); }
    else if (mode == M_GELU) { r.x = gelu_as(x.x); r.y = gelu_as(x.y); r.z = gelu_as(x.z); r.w = gelu_as(x.w); }
    else if (mode == M_SIG) { r.x = sigmoidf_(x.x); r.y = sigmoidf_(x.y); r.z = sigmoidf_(x.z); r.w = sigmoidf_(x.w); }
    else if (mode == M_FG) { r.x = sigmoidf_(x.x); r.y = sigmoidf_(x.y); r.z = sigmoidf_(x.z); r.w = sigmoidf_(x.w); r = lb + (1.0f - lb) * r; }
    return r;
}
struct EpiIn {
    static constexpr bool PERM = true, AFTER_DRAIN = false, KEEP = false;
    unsigned char* ws; const float* hg_lb; const float* A_log; const float* dt_bias; int layer;
    __device__ __forceinline__ void operator()(const f32x4 (&acc)[2][2][4][2], const pg8::Unit& u, int wr, int wc, int fr, int fq) const {
        const int pn = u.pn;
        const float* hg_lb = this->hg_lb; const float* A_log = this->A_log; const float* dt_bias = this->dt_bias; unsigned char* ws = this->ws;
        asm volatile("" : "+s"(hg_lb), "+s"(A_log), "+s"(dt_bias), "+s"(ws));
        if (pn == 68) {
            if (wc != 0) return;
            float* GAB = (float*)(ws + WS_GAB);
#pragma unroll
            for (int n = 0; n < 2; ++n) {
                f32x4 al = (f32x4){0.f, 0.f, 0.f, 0.f}, db = al;
                if (fq < 2) { const f32x4 A = *(const f32x4*)(A_log + (layer * 2 + fq) * 8 + 4 * n); db = *(const f32x4*)(dt_bias + (layer * 2 + fq) * 8 + 4 * n);
                    al.x = -__expf(A.x); al.y = -__expf(A.y); al.z = -__expf(A.z); al.w = -__expf(A.w); }
#pragma unroll
                for (int ai = 0; ai < 2; ++ai)
#pragma unroll
                    for (int m = 0; m < 4; ++m) { const int row = u.pm * 256 + ai * 128 + wr * 64 + m * 16 + fr;
                        const f32x4 x = acc[ai][0][m][n]; f32x4 y;
                        if (fq < 2) { const f32x4 z = x + db;
                            y.x = al.x * ((z.x > 20.f) ? z.x : log1pf(__expf(z.x))); y.y = al.y * ((z.y > 20.f) ? z.y : log1pf(__expf(z.y)));
                            y.z = al.z * ((z.z > 20.f) ? z.z : log1pf(__expf(z.z))); y.w = al.w * ((z.w > 20.f) ? z.w : log1pf(__expf(z.w))); }
                        else { y.x = sigmoidf_(x.x); y.y = sigmoidf_(x.y); y.z = sigmoidf_(x.z); y.w = sigmoidf_(x.w); }
                        *(f32x4*)(GAB + (size_t)row * 32 + 8 * fq + 4 * n) = y;
                        asm volatile("" ::: "memory"); }
            }
            return;
        }
        int mode, ld, cb; size_t off; bool f32o = false; int dir = 0;
        if (pn < 4) { mode = M_SILU; off = WS_HQ; ld = 1024; cb = pn * 256; }
        else if (pn < 8) { mode = M_ID; off = WS_HI; ld = 1024; cb = (pn - 4) * 256; }
        else if (pn < 12) { mode = M_SILU; off = WS_HGO; ld = 1024; cb = (pn - 8) * 256; }
        else if (pn < 16) { mode = M_FG; off = WS_FF; ld = 1024; cb = (pn - 12) * 256; f32o = true; dir = 0; }
        else if (pn < 20) { mode = M_FG; off = WS_FB; ld = 1024; cb = (pn - 16) * 256; f32o = true; dir = 1; }
        else if (pn < 24) { mode = M_GELU; off = WS_CU; ld = 1024; cb = (pn - 20) * 256; }
        else if (pn < 28) { mode = M_GELU; off = WS_CV; ld = 1024; cb = (pn - 24) * 256; }
        else if (pn < 40) { mode = M_ID; off = WS_GQKV; ld = 3072; cb = (pn - 28) * 256; }
        else if (pn < 44) { mode = M_SILU; off = WS_GGO; ld = 1024; cb = (pn - 40) * 256; }
        else { mode = M_SIG; off = WS_GATES; ld = 6144; cb = (pn - 44) * 256; }
        unsigned char* base = ws + off;
#pragma unroll
        for (int bj = 0; bj < 2; ++bj) {
            const int col = cb + bj * 128 + wc * 32 + 8 * fq;
            f32x4 lb0 = (f32x4){0.f, 0.f, 0.f, 0.f}, lb1 = lb0;
            if (mode == M_FG && layer == 1) {
                const f32x4 a0 = *(const f32x4*)(hg_lb + dir * 1024 + col), a1 = *(const f32x4*)(hg_lb + dir * 1024 + col + 4);
                const f32x4 b0 = *(const f32x4*)(hg_lb + (2 + dir) * 1024 + col), b1 = *(const f32x4*)(hg_lb + (2 + dir) * 1024 + col + 4);
                lb0.x = sigmoidf_(b0.x - a0.x); lb0.y = sigmoidf_(b0.y - a0.y); lb0.z = sigmoidf_(b0.z - a0.z); lb0.w = sigmoidf_(b0.w - a0.w);
                lb1.x = sigmoidf_(b1.x - a1.x); lb1.y = sigmoidf_(b1.y - a1.y); lb1.z = sigmoidf_(b1.z - a1.z); lb1.w = sigmoidf_(b1.w - a1.w);
            }
#pragma unroll
            for (int ai = 0; ai < 2; ++ai)
#pragma unroll
                for (int m = 0; m < 4; ++m) { const int row = u.pm * 256 + ai * 128 + wr * 64 + m * 16 + fr;
                    const f32x4 y0 = act4(acc[ai][bj][m][0], mode, lb0), y1 = act4(acc[ai][bj][m][1], mode, lb1);
                    if (f32o) { float* dst = (float*)base + (size_t)row * ld + col; *(f32x4*)dst = y0; *(f32x4*)(dst + 4) = y1; }
                    else { bf16_t* dst = (bf16_t*)base + (size_t)row * ld + col;
                        u32x4 w; w.x = pk2(y0.x, y0.y); w.y = pk2(y0.z, y0.w); w.z = pk2(y1.x, y1.y); w.w = pk2(y1.z, y1.w); *(u32x4*)dst = w; }
                    asm volatile("" ::: "memory");
                }
        }
    }
};
struct Br3Order {
    pg8::StaticOrder base;
    __device__ __forceinline__ bool next(int i, pg8::Unit& u) const { const int rd = i / 3, br = i - 3 * rd; pg8::Unit ub; if (!base.next(rd, ub)) return false; u.pm = br * 32 + ub.pm; u.pn = br * 8 + ub.pn; return true; }
    __device__ __forceinline__ void a_ready(const pg8::Unit&) const {}
    __device__ __forceinline__ void done(const pg8::Unit&) const {}
};
struct EpiBr3 {
    static constexpr bool PERM = true, AFTER_DRAIN = false, KEEP = true;
    unsigned char* ws;
    __device__ __forceinline__ bool keep(const pg8::Unit& u) const { return u.pm < 64; }
    __device__ __forceinline__ void operator()(f32x4 (&acc)[2][2][4][2], const pg8::Unit& u, int wr, int wc, int fr, int fq) const {
        const bf16_t* GATES = (const bf16_t*)(ws + WS_GATES); bf16_t* MG = (bf16_t*)(ws + WS_MERGED);
        const int br = u.pm >> 5, pm = u.pm & 31, pn = u.pn & 7;
#pragma unroll
        for (int ai = 0; ai < 2; ++ai)
#pragma unroll
            for (int m = 0; m < 4; ++m) { const int row = pm * 256 + ai * 128 + wr * 64 + m * 16 + fr;
#pragma unroll
                for (int bj = 0; bj < 2; ++bj) { const int col = pn * 256 + bj * 128 + wc * 32 + 8 * fq;
                    const bf16_t* gp = GATES + (size_t)row * 6144 + col;
                    const u32x4 gw = *(const u32x4*)(gp + br * 2048);
                    f32x4 c0 = (f32x4){bf_lo(gw.x), bf_hi(gw.x), bf_lo(gw.y), bf_hi(gw.y)}, c1 = (f32x4){bf_lo(gw.z), bf_hi(gw.z), bf_lo(gw.w), bf_hi(gw.w)};
                    if (br > 0) { c0 = __builtin_elementwise_max(c0, (f32x4){1e-6f, 1e-6f, 1e-6f, 1e-6f}); c1 = __builtin_elementwise_max(c1, (f32x4){1e-6f, 1e-6f, 1e-6f, 1e-6f}); }
                    if (br < 2) { const u32x4 gn = *(const u32x4*)(gp + (br + 1) * 2048);
                        f32x4 n0 = (f32x4){bf_lo(gn.x), bf_hi(gn.x), bf_lo(gn.y), bf_hi(gn.y)}, n1 = (f32x4){bf_lo(gn.z), bf_hi(gn.z), bf_lo(gn.w), bf_hi(gn.w)};
                        n0 = __builtin_elementwise_max(n0, (f32x4){1e-6f, 1e-6f, 1e-6f, 1e-6f}); n1 = __builtin_elementwise_max(n1, (f32x4){1e-6f, 1e-6f, 1e-6f, 1e-6f});
                        c0.x *= __builtin_amdgcn_rcpf(n0.x); c0.y *= __builtin_amdgcn_rcpf(n0.y); c0.z *= __builtin_amdgcn_rcpf(n0.z); c0.w *= __builtin_amdgcn_rcpf(n0.w);
                        c1.x *= __builtin_amdgcn_rcpf(n1.x); c1.y *= __builtin_amdgcn_rcpf(n1.y); c1.z *= __builtin_amdgcn_rcpf(n1.z); c1.w *= __builtin_amdgcn_rcpf(n1.w);
                        acc[ai][bj][m][0] *= c0; acc[ai][bj][m][1] *= c1; }
                    else { const f32x4 v0 = acc[ai][bj][m][0] * c0, v1 = acc[ai][bj][m][1] * c1;
                        u32x4 w; w.x = pk2(v0[0], v0[1]); w.y = pk2(v0[2], v0[3]); w.z = pk2(v1[0], v1[1]); w.w = pk2(v1[2], v1[3]); *(u32x4*)(MG + (size_t)row * D + col) = w; }
                } }
    }
};
struct EpiRes {
    static constexpr bool PERM = true, AFTER_DRAIN = false, KEEP = false;
    unsigned char* ws; int layer, goff;
    __device__ __forceinline__ void operator()(const f32x4 (&acc)[2][2][4][2], const pg8::Unit& u, int wr, int wc, int fr, int fq) const {
        bf16_t* X = (bf16_t*)(ws + WS_X); const float* MOD = (const float*)(ws + WS_MOD);
#pragma unroll
        for (int ai = 0; ai < 2; ++ai)
#pragma unroll
            for (int m = 0; m < 4; ++m) { const int row = u.pm * 256 + ai * 128 + wr * 64 + m * 16 + fr;
                const float* gate = MOD + (size_t)(layer * 5 + mod_vec_of_row(row)) * 12288 + goff;
#pragma unroll
                for (int bj = 0; bj < 2; ++bj) { const int col = u.pn * 256 + bj * 128 + wc * 32 + 8 * fq;
                    bf16_t* x = X + (size_t)row * D + col;
                    const f32x4 g0 = *(const f32x4*)(gate + col), g1 = *(const f32x4*)(gate + col + 4);
                    const u32x4 p = *(const u32x4*)x;
                    const f32x4 y0 = (f32x4){bf_lo(p.x), bf_hi(p.x), bf_lo(p.y), bf_hi(p.y)} + g0 * acc[ai][bj][m][0], y1 = (f32x4){bf_lo(p.z), bf_hi(p.z), bf_lo(p.w), bf_hi(p.w)} + g1 * acc[ai][bj][m][1];
                    u32x4 w; w.x = pk2(y0.x, y0.y); w.y = pk2(y0.z, y0.w); w.z = pk2(y1.x, y1.y); w.w = pk2(y1.z, y1.w); *(u32x4*)x = w; } }
    }
};
struct EpiRelu2 {
    static constexpr bool PERM = true, AFTER_DRAIN = false, KEEP = false;
    unsigned char* ws;
    __device__ __forceinline__ void operator()(const f32x4 (&acc)[2][2][4][2], const pg8::Unit& u, int wr, int wc, int fr, int fq) const {
        bf16_t* FH = (bf16_t*)(ws + WS_FFH);
#pragma unroll
        for (int ai = 0; ai < 2; ++ai)
#pragma unroll
            for (int m = 0; m < 4; ++m) { const int row = u.pm * 256 + ai * 128 + wr * 64 + m * 16 + fr;
#pragma unroll
                for (int bj = 0; bj < 2; ++bj) { const int col = u.pn * 256 + bj * 128 + wc * 32 + 8 * fq;
                    f32x4 v0 = acc[ai][bj][m][0], v1 = acc[ai][bj][m][1];
                    v0 = __builtin_elementwise_max(v0, (f32x4){0.f, 0.f, 0.f, 0.f}); v1 = __builtin_elementwise_max(v1, (f32x4){0.f, 0.f, 0.f, 0.f}); v0 *= v0; v1 *= v1;
                    u32x4 w; w.x = pk2(v0[0], v0[1]); w.y = pk2(v0[2], v0[3]); w.z = pk2(v1[0], v1[1]); w.w = pk2(v1[2], v1[3]);
                    *(u32x4*)(FH + (size_t)row * DFF + col) = w; } }
    }
};

__device__ __forceinline__ void phase_gdn_prep(KArgs& a, int l) {
    const int tid = otid(), lane = tid & 63, wave = tid >> 6, gw = blockIdx.x * 8 + wave, NGW = gridDim.x * 8;
    const int sub = lane >> 4, l16 = lane & 15;
    const bf16_t* RAW = (const bf16_t*)(a.ws + WS_GQKV);
    const float* CW = a.in[16] + (size_t)l * 9 * 3072;
    for (int it = gw * 4 + sub; it < NTOK * 24; it += NGW * 4) {
        const int r = it / 24, ch = it - r * 24, c = ch * 128 + 8 * l16;
        const bool ctx = r < NCTX;
        const int t = ctx ? (r & 255) : ((r - NCTX) & 1023), gr = t >> 6, gc = t & 63;
        float y[8];
#pragma unroll
        for (int e = 0; e < 8; ++e) y[e] = 0.f;
#pragma unroll
        for (int i = 0; i < 3; ++i)
#pragma unroll
            for (int j = 0; j < 3; ++j) {
                bool valid; int dr;
                if (ctx) { const int tt = t + j - 1; valid = (i == 1) && tt >= 0 && tt < 256; dr = j - 1; }
                else { const int rr = gr + i - 1, cc = gc + j - 1; valid = rr >= 0 && rr < 16 && cc >= 0 && cc < 64; dr = (i - 1) * 64 + (j - 1); }
                if (valid) { const u32x4 w = *(const u32x4*)(RAW + (size_t)(r + dr) * 3072 + c);
                    const f32x4 c0 = *(const f32x4*)(CW + (i * 3 + j) * 3072 + c), c1 = *(const f32x4*)(CW + (i * 3 + j) * 3072 + c + 4);
                    y[0] += c0.x * bf_lo(w.x); y[1] += c0.y * bf_hi(w.x); y[2] += c0.z * bf_lo(w.y); y[3] += c0.w * bf_hi(w.y);
                    y[4] += c1.x * bf_lo(w.z); y[5] += c1.y * bf_hi(w.z); y[6] += c1.z * bf_lo(w.w); y[7] += c1.w * bf_hi(w.w); }
            }
        float ss = 0.f;
#pragma unroll
        for (int e = 0; e < 8; ++e) { y[e] = siluf_(y[e]); ss += y[e] * y[e]; }
        ss = red16(ss);
        float sc = 1.0f;
        if (ch < 16) sc = rsqrtf(ss + EPS) * (ch < 8 ? 0.08838834764831845f : 1.0f);
        bf16_t* dst = (bf16_t*)(a.ws + (ch < 8 ? WS_GQ : (ch < 16 ? WS_GK : WS_GV))) + (size_t)r * 1024 + (ch & 7) * 128 + 8 * l16;
        { u32x4 o; o.x = pk2(y[0] * sc, y[1] * sc); o.y = pk2(y[2] * sc, y[3] * sc); o.z = pk2(y[4] * sc, y[5] * sc); o.w = pk2(y[6] * sc, y[7] * sc); *(u32x4*)dst = o; }
    }
}

constexpr int HC_QT = 0, HC_KT = 4352, HC_KD = 8704, HC_VT = 18944, HC_G = 29184, HC_BUF = 29696, HC_TOT = 2 * HC_BUF;
__device__ __forceinline__ void hgrn_chunk_item(KArgs& a, LAS unsigned char* lds, int l, int s, int h, int dir) {
    const int tid = otid(), lane = tid & 63, w = tid >> 6, fr = lane & 15, fq = lane >> 4;
    const int d = tid & 127, part = tid >> 7;
    const int L = (s < 16) ? 256 : 1024, row0 = (s < 16) ? s * 256 : NCTX + (s - 16) * 1024, nchunk = L / 16;
    f32x4 acc[8];
    if (s >= 16) { const float* st = a.in[3] + ((((size_t)(s - 16) * 2 + l) * 2 + dir) * 8 + h) * 16384;
#pragma unroll
        for (int dt = 0; dt < 8; ++dt)
#pragma unroll
            for (int jj = 0; jj < 4; ++jj) acc[dt][jj] = st[(16 * dt + 4 * fq + jj) * 128 + 16 * w + fr]; }
    else {
#pragma unroll
        for (int dt = 0; dt < 8; ++dt) acc[dt] = (f32x4){0.f, 0.f, 0.f, 0.f}; }
    const float* F = (const float*)(a.ws + (dir ? WS_FB : WS_FF));
    const bf16_t* HQ = (const bf16_t*)(a.ws + WS_HQ); const bf16_t* HI = (const bf16_t*)(a.ws + WS_HI);
    bf16_t* OS = (bf16_t*)(a.ws + WS_OSH) + (size_t)dir * NTOK * 1024;
    LAS float* TOT = (LAS float*)(lds + HC_TOT);
    float pf[4]; unsigned pq[4], pv[4];
#define HC_ROW(c, j) (row0 + (dir ? L - 1 - (16 * (c) + (j)) : 16 * (c) + (j)))
#define HC_PREFETCH(c) do { _Pragma("unroll") for (int i = 0; i < 4; ++i) { const size_t o_ = (size_t)HC_ROW(c, 4 * part + i) * 1024 + h * 128 + d; pf[i] = F[o_]; pq[i] = HQ[o_]; pv[i] = HI[o_]; } } while (0)
    HC_PREFETCH(0);
    float cs[4], omf[4], qf[4];
    { LAS unsigned char* B = lds;
        { float run = 0.f;
#pragma unroll
          for (int i = 0; i < 4; ++i) { run += __logf(fmaxf(pf[i], 1e-30f)); cs[i] = run; omf[i] = 1.0f - pf[i]; qf[i] = __builtin_bit_cast(float, pq[i] << 16); } }
        TOT[part * 128 + d] = cs[3];
        { u32x2 t; t.x = pv[0] | (pv[1] << 16); t.y = pv[2] | (pv[3] << 16); *(LAS u32x2*)(B + HC_VT + d * 80 + 8 * part) = t; }
        if (1 < nchunk) HC_PREFETCH(1);
        LDS_BARRIER();
        { const float t0 = TOT[d], t1 = TOT[128 + d], t2 = TOT[256 + d], t3 = TOT[384 + d];
          const float pre = (part > 0 ? t0 : 0.f) + (part > 1 ? t1 : 0.f) + (part > 2 ? t2 : 0.f), blast = (t0 + t1) + (t2 + t3);
          float kd[4];
#pragma unroll
          for (int i = 0; i < 4; ++i) { const float b = pre + cs[i];
              const unsigned qk = pk2(qf[i] * __expf(b), omf[i] * __expf(fminf(-b, 80.0f)));
              ((LAS bf16_t*)(B + HC_QT))[(4 * part + i) * 136 + d] = (bf16_t)(qk & 0xffffu);
              ((LAS bf16_t*)(B + HC_KT))[(4 * part + i) * 136 + d] = (bf16_t)(qk >> 16);
              kd[i] = omf[i] * __expf(blast - b); }
          { u32x2 t; t.x = pk2(kd[0], kd[1]); t.y = pk2(kd[2], kd[3]); *(LAS u32x2*)(B + HC_KD + d * 80 + 8 * part) = t; }
          if (part == 0) ((LAS float*)(B + HC_G))[d] = __expf(blast); }
        LDS_BARRIER(); }
    for (int c = 0; c < nchunk; ++c) {
        const bool hn = c + 1 < nchunk;
        if (hn) { LAS unsigned char* B = lds + ((c + 1) & 1) * HC_BUF;
        { float run = 0.f;
#pragma unroll
          for (int i = 0; i < 4; ++i) { run += __logf(fmaxf(pf[i], 1e-30f)); cs[i] = run; omf[i] = 1.0f - pf[i]; qf[i] = __builtin_bit_cast(float, pq[i] << 16); } }
        TOT[part * 128 + d] = cs[3];
        { u32x2 t; t.x = pv[0] | (pv[1] << 16); t.y = pv[2] | (pv[3] << 16); *(LAS u32x2*)(B + HC_VT + d * 80 + 8 * part) = t; }
            if (c + 2 < nchunk) HC_PREFETCH(c + 2); }
        LDS_BARRIER();
        if (hn) { LAS unsigned char* B = lds + ((c + 1) & 1) * HC_BUF;
        { const float t0 = TOT[d], t1 = TOT[128 + d], t2 = TOT[256 + d], t3 = TOT[384 + d];
          const float pre = (part > 0 ? t0 : 0.f) + (part > 1 ? t1 : 0.f) + (part > 2 ? t2 : 0.f), blast = (t0 + t1) + (t2 + t3);
          float kd[4];
#pragma unroll
          for (int i = 0; i < 4; ++i) { const float b = pre + cs[i];
              const unsigned qk = pk2(qf[i] * __expf(b), omf[i] * __expf(fminf(-b, 80.0f)));
              ((LAS bf16_t*)(B + HC_QT))[(4 * part + i) * 136 + d] = (bf16_t)(qk & 0xffffu);
              ((LAS bf16_t*)(B + HC_KT))[(4 * part + i) * 136 + d] = (bf16_t)(qk >> 16);
              kd[i] = omf[i] * __expf(blast - b); }
          { u32x2 t; t.x = pk2(kd[0], kd[1]); t.y = pk2(kd[2], kd[3]); *(LAS u32x2*)(B + HC_KD + d * 80 + 8 * part) = t; }
          if (part == 0) ((LAS float*)(B + HC_G))[d] = __expf(blast); }
        }
        { LAS unsigned char* B = lds + (c & 1) * HC_BUF;
        f32x4 A = (f32x4){0.f, 0.f, 0.f, 0.f};
#pragma unroll
        for (int ks = 0; ks < 4; ++ks) { const bf16x8 kf = *(const LAS bf16x8*)(B + HC_KT + fr * 272 + 64 * ks + 16 * fq), qfr = *(const LAS bf16x8*)(B + HC_QT + fr * 272 + 64 * ks + 16 * fq);
            A = __builtin_amdgcn_mfma_f32_16x16x32_bf16(kf, qfr, A, 0, 0, 0); }
#pragma unroll
        for (int jj = 0; jj < 4; ++jj) if (4 * fq + jj > fr) A[jj] = 0.f;
        u32x4 af; af.x = pk2(A[0], A[1]); af.y = pk2(A[2], A[3]); af.z = 0u; af.w = 0u;
        u32x4 vf; { const u32x2 t = *(const LAS u32x2*)(B + HC_VT + (16 * w + fr) * 80 + 8 * fq); vf.x = t.x; vf.y = t.y; vf.z = 0u; vf.w = 0u; }
        f32x4 o = __builtin_amdgcn_mfma_f32_16x16x32_bf16(__builtin_bit_cast(bf16x8, af), __builtin_bit_cast(bf16x8, vf), (f32x4){0.f, 0.f, 0.f, 0.f}, 0, 0, 0);
#pragma unroll
        for (int ks = 0; ks < 4; ++ks) {
            const u32x2 qa = *(const LAS u32x2*)(B + HC_QT + fr * 272 + 64 * ks + 8 * fq), qb = *(const LAS u32x2*)(B + HC_QT + fr * 272 + 64 * ks + 32 + 8 * fq);
            u32x4 q2; q2.x = qa.x; q2.y = qa.y; q2.z = qb.x; q2.w = qb.y;
            u32x4 sf; sf.x = pk2(acc[2 * ks][0], acc[2 * ks][1]); sf.y = pk2(acc[2 * ks][2], acc[2 * ks][3]); sf.z = pk2(acc[2 * ks + 1][0], acc[2 * ks + 1][1]); sf.w = pk2(acc[2 * ks + 1][2], acc[2 * ks + 1][3]);
            o = __builtin_amdgcn_mfma_f32_16x16x32_bf16(__builtin_bit_cast(bf16x8, q2), __builtin_bit_cast(bf16x8, sf), o, 0, 0, 0); }
#pragma unroll
        for (int jj = 0; jj < 4; jj += 2) { const unsigned op = pk2(o[jj], o[jj + 1]);
            OS[(size_t)HC_ROW(c, 4 * fq + jj) * 1024 + h * 128 + 16 * w + fr] = (bf16_t)(op & 0xffffu); OS[(size_t)HC_ROW(c, 4 * fq + jj + 1) * 1024 + h * 128 + 16 * w + fr] = (bf16_t)(op >> 16); }
#pragma unroll
        for (int dt = 0; dt < 8; ++dt) { const f32x4 g4 = *(const LAS f32x4*)(B + HC_G + (16 * dt + 4 * fq) * 4);
            u32x4 kf; { const u32x2 t = *(const LAS u32x2*)(B + HC_KD + (16 * dt + fr) * 80 + 8 * fq); kf.x = t.x; kf.y = t.y; kf.z = 0u; kf.w = 0u; }
            acc[dt] = __builtin_amdgcn_mfma_f32_16x16x32_bf16(__builtin_bit_cast(bf16x8, kf), __builtin_bit_cast(bf16x8, vf), acc[dt] * g4, 0, 0, 0); }
        }
        LDS_BARRIER();
    }
#undef HC_ROW
#undef HC_PREFETCH
    if (s < 16) { float* so = a.out + OUT_SHG + ((((size_t)s * 2 + l) * 2 + dir) * 8 + h) * 16384;
#pragma unroll
        for (int dt = 0; dt < 8; ++dt)
#pragma unroll
            for (int jj = 0; jj < 4; ++jj) so[(16 * dt + 4 * fq + jj) * 128 + 16 * w + fr] = acc[dt][jj]; }
    __syncthreads();
}


constexpr int GC_KT = 0, GC_QT = 4352, GC_V = 8704, GC_KD = 16896, GC_GS = 27136, GC_BS = 27200, GC_GC = 27264, GC_EG = 27328, GC_AQ = 27392, GC_TT = 27904, GC_BUF = 28416, GC_PRIV = 2 * GC_BUF;
static_assert(GC_PRIV + 1024 <= LDS_MISC, "GDN chunk LDS map");
__device__ __forceinline__ void gdn_chunk_item(KArgs& a, LAS unsigned char* lds, int l, int s, int h, int dir) {
    const int tid = otid(), lane = tid & 63, w = tid >> 6, fr = lane & 15, fq = lane >> 4;
    const int d = tid & 127, part = tid >> 7;
    const int L = (s < 16) ? 256 : 1024, row0 = (s < 16) ? s * 256 : NCTX + (s - 16) * 1024, nchunk = L / 16;
    f32x4 acc[8];
    if (s >= 16) { const float* st = a.in[4] + ((((size_t)(s - 16) * 2 + l) * 2 + dir) * 8 + h) * 16384;
#pragma unroll
        for (int dt = 0; dt < 8; ++dt)
#pragma unroll
            for (int jj = 0; jj < 4; ++jj) acc[dt][jj] = st[(16 * dt + 4 * fq + jj) * 128 + 16 * w + fr]; }
    else {
#pragma unroll
        for (int dt = 0; dt < 8; ++dt) acc[dt] = (f32x4){0.f, 0.f, 0.f, 0.f}; }
    const bf16_t* GK = (const bf16_t*)(a.ws + WS_GK); const bf16_t* GQ = (const bf16_t*)(a.ws + WS_GQ); const bf16_t* GV = (const bf16_t*)(a.ws + WS_GV); const float* GAB = (const float*)(a.ws + WS_GAB);
    bf16_t* OS = (bf16_t*)(a.ws + WS_OSG) + (size_t)dir * NTOK * 1024;
    LAS float* KKs = (LAS float*)(lds + GC_PRIV);
    unsigned pk_[4], pq_[4], pv_[4]; float pg_ = 0.f, pb_ = 0.f;
#define GC_ROW(c, j) (row0 + (dir ? L - 1 - (16 * (c) + (j)) : 16 * (c) + (j)))
#define GC_PREFETCH(c) do { _Pragma("unroll") for (int i = 0; i < 4; ++i) { const size_t o_ = (size_t)GC_ROW(c, 4 * part + i) * 1024 + h * 128 + d; pk_[i] = GK[o_]; pq_[i] = GQ[o_]; pv_[i] = GV[o_]; } \
        if (tid < 16) { const size_t r_ = (size_t)GC_ROW(c, tid) * 32; pg_ = GAB[r_ + dir * 8 + h]; pb_ = GAB[r_ + 16 + dir * 8 + h]; } } while (0)
#define GC_TSTAGE(Bp) do { LAS unsigned char* Bt_ = (Bp); \
        const LAS float* GCa_ = (const LAS float*)(Bt_ + GC_GC); const LAS float* BSa_ = (const LAS float*)(Bt_ + GC_BS); \
        f32x4 Gm_ = (f32x4){0.f, 0.f, 0.f, 0.f}, Aq_ = Gm_; \
        _Pragma("unroll") for (int ks = 0; ks < 4; ++ks) { const bf16x8 kfr_ = *(const LAS bf16x8*)(Bt_ + GC_KT + fr * 272 + 64 * ks + 16 * fq), qfr_ = *(const LAS bf16x8*)(Bt_ + GC_QT + fr * 272 + 64 * ks + 16 * fq); \
            Gm_ = __builtin_amdgcn_mfma_f32_16x16x32_bf16(kfr_, kfr_, Gm_, 0, 0, 0); Aq_ = __builtin_amdgcn_mfma_f32_16x16x32_bf16(kfr_, qfr_, Aq_, 0, 0, 0); } \
        const float gct_ = GCa_[fr], bet_ = BSa_[fr]; const f32x4 gc4_ = *(const LAS f32x4*)(GCa_ + 4 * fq); \
        f32x4 KK_; \
        _Pragma("unroll") for (int jj = 0; jj < 4; ++jj) { const float dec_ = __expf(fminf(gct_ - gc4_[jj], 0.f)); const int sidx_ = 4 * fq + jj; \
            KK_[jj] = (sidx_ < fr) ? bet_ * Gm_[jj] * dec_ : 0.f; Aq_[jj] = (sidx_ <= fr) ? Aq_[jj] * dec_ : 0.f; } \
        *(LAS f32x4*)(KKs + fr * 16 + 4 * fq) = KK_; \
        { u32x2 t_; t_.x = pk2(Aq_[0], Aq_[1]); t_.y = pk2(Aq_[2], Aq_[3]); *(LAS u32x2*)(Bt_ + GC_AQ + fr * 32 + 8 * fq) = t_; } \
        asm volatile("s_waitcnt lgkmcnt(0)" ::: "memory"); \
        float x_[16]; \
        _Pragma("unroll") for (int t = 0; t < 16; ++t) x_[t] = (t == fr) ? 1.0f : 0.0f; \
        _Pragma("unroll") for (int t = 1; t < 16; ++t) { float sa_ = 0.f; \
            _Pragma("unroll") for (int sb = 0; sb < (t + 3) / 4; ++sb) { const f32x4 kk_ = *(const LAS f32x4*)(KKs + t * 16 + 4 * sb); \
                sa_ += (kk_.x * x_[4 * sb] + kk_.y * x_[4 * sb + 1]) + (kk_.z * x_[4 * sb + 2] + kk_.w * x_[4 * sb + 3]); } \
            x_[t] -= sa_; } \
        _Pragma("unroll") for (int e = 0; e < 4; e += 2) { \
            const float ta_ = (fq == 0) ? x_[e] : ((fq == 1) ? x_[4 + e] : ((fq == 2) ? x_[8 + e] : x_[12 + e])); \
            const float tb_ = (fq == 0) ? x_[e + 1] : ((fq == 1) ? x_[5 + e] : ((fq == 2) ? x_[9 + e] : x_[13 + e])); \
            const unsigned tp_ = pk2(ta_, tb_); \
            ((LAS bf16_t*)(Bt_ + GC_TT))[(4 * fq + e) * 16 + fr] = (bf16_t)(tp_ & 0xffffu); ((LAS bf16_t*)(Bt_ + GC_TT))[(4 * fq + e + 1) * 16 + fr] = (bf16_t)(tp_ >> 16); } \
    } while (0)
    GC_PREFETCH(0);
    float kf[4];
    { LAS unsigned char* B = lds;
#pragma unroll
        for (int i = 0; i < 4; ++i) { kf[i] = __builtin_bit_cast(float, pk_[i] << 16);
            ((LAS bf16_t*)(B + GC_KT))[(4 * part + i) * 136 + d] = (bf16_t)pk_[i];
            ((LAS bf16_t*)(B + GC_QT))[(4 * part + i) * 136 + d] = (bf16_t)pq_[i];
            ((LAS float*)(B + GC_V))[(4 * part + i) * 128 + d] = __builtin_bit_cast(float, pv_[i] << 16); }
        if (tid < 16) { ((LAS float*)(B + GC_GS))[tid] = pg_; ((LAS float*)(B + GC_BS))[tid] = pb_; }
        if (1 < nchunk) GC_PREFETCH(1);
        LDS_BARRIER();
        { const LAS float* GS = (const LAS float*)(B + GC_GS);
          const f32x4 g0 = *(const LAS f32x4*)(GS), g1 = *(const LAS f32x4*)(GS + 4), g2 = *(const LAS f32x4*)(GS + 8), g3 = *(const LAS f32x4*)(GS + 12);
          const float s0 = (g0.x + g0.y) + (g0.z + g0.w), s1 = (g1.x + g1.y) + (g1.z + g1.w), s2 = (g2.x + g2.y) + (g2.z + g2.w), s3 = (g3.x + g3.y) + (g3.z + g3.w);
          const float glast = (s0 + s1) + (s2 + s3);
          { const float pre = (part > 0 ? s0 : 0.f) + (part > 1 ? s1 : 0.f) + (part > 2 ? s2 : 0.f);
            const f32x4 gl = *(const LAS f32x4*)(GS + 4 * part);
            const float c0 = pre + gl.x, c1 = c0 + gl.y, c2 = c1 + gl.z, c3 = c2 + gl.w;
            u32x2 t; t.x = pk2(kf[0] * __expf(glast - c0), kf[1] * __expf(glast - c1)); t.y = pk2(kf[2] * __expf(glast - c2), kf[3] * __expf(glast - c3));
            *(LAS u32x2*)(B + GC_KD + d * 80 + 8 * part) = t; }
          if (tid < 16) { const int p2 = tid >> 2, i2 = tid & 3;
            const float pre = (p2 > 0 ? s0 : 0.f) + (p2 > 1 ? s1 : 0.f) + (p2 > 2 ? s2 : 0.f);
            const f32x4 gl = *(const LAS f32x4*)(GS + 4 * p2);
            const float c0 = pre + gl.x, c1 = c0 + gl.y, c2 = c1 + gl.z, c3 = c2 + gl.w;
            const float gcv = (i2 == 0) ? c0 : ((i2 == 1) ? c1 : ((i2 == 2) ? c2 : c3));
            ((LAS float*)(B + GC_GC))[tid] = gcv; ((LAS float*)(B + GC_EG))[tid] = __expf(gcv); } }
        if (w == 0) GC_TSTAGE(B);
        LDS_BARRIER(); }
    for (int c = 0; c < nchunk; ++c) {
        const bool hn = c + 1 < nchunk;
        if (hn) { LAS unsigned char* B = lds + ((c + 1) & 1) * GC_BUF;
#pragma unroll
        for (int i = 0; i < 4; ++i) { kf[i] = __builtin_bit_cast(float, pk_[i] << 16);
            ((LAS bf16_t*)(B + GC_KT))[(4 * part + i) * 136 + d] = (bf16_t)pk_[i];
            ((LAS bf16_t*)(B + GC_QT))[(4 * part + i) * 136 + d] = (bf16_t)pq_[i];
            ((LAS float*)(B + GC_V))[(4 * part + i) * 128 + d] = __builtin_bit_cast(float, pv_[i] << 16); }
        if (tid < 16) { ((LAS float*)(B + GC_GS))[tid] = pg_; ((LAS float*)(B + GC_BS))[tid] = pb_; }
            if (c + 2 < nchunk) GC_PREFETCH(c + 2); }
        LDS_BARRIER();
        if (hn) { LAS unsigned char* B = lds + ((c + 1) & 1) * GC_BUF;
        { const LAS float* GS = (const LAS float*)(B + GC_GS);
          const f32x4 g0 = *(const LAS f32x4*)(GS), g1 = *(const LAS f32x4*)(GS + 4), g2 = *(const LAS f32x4*)(GS + 8), g3 = *(const LAS f32x4*)(GS + 12);
          const float s0 = (g0.x + g0.y) + (g0.z + g0.w), s1 = (g1.x + g1.y) + (g1.z + g1.w), s2 = (g2.x + g2.y) + (g2.z + g2.w), s3 = (g3.x + g3.y) + (g3.z + g3.w);
          const float glast = (s0 + s1) + (s2 + s3);
          { const float pre = (part > 0 ? s0 : 0.f) + (part > 1 ? s1 : 0.f) + (part > 2 ? s2 : 0.f);
            const f32x4 gl = *(const LAS f32x4*)(GS + 4 * part);
            const float c0 = pre + gl.x, c1 = c0 + gl.y, c2 = c1 + gl.z, c3 = c2 + gl.w;
            u32x2 t; t.x = pk2(kf[0] * __expf(glast - c0), kf[1] * __expf(glast - c1)); t.y = pk2(kf[2] * __expf(glast - c2), kf[3] * __expf(glast - c3));
            *(LAS u32x2*)(B + GC_KD + d * 80 + 8 * part) = t; }
          if (tid < 16) { const int p2 = tid >> 2, i2 = tid & 3;
            const float pre = (p2 > 0 ? s0 : 0.f) + (p2 > 1 ? s1 : 0.f) + (p2 > 2 ? s2 : 0.f);
            const f32x4 gl = *(const LAS f32x4*)(GS + 4 * p2);
            const float c0 = pre + gl.x, c1 = c0 + gl.y, c2 = c1 + gl.z, c3 = c2 + gl.w;
            const float gcv = (i2 == 0) ? c0 : ((i2 == 1) ? c1 : ((i2 == 2) ? c2 : c3));
            ((LAS float*)(B + GC_GC))[tid] = gcv; ((LAS float*)(B + GC_EG))[tid] = __expf(gcv); } }
        if (w == 0) GC_TSTAGE(B);
        }
        { LAS unsigned char* B = lds + (c & 1) * GC_BUF;
        const LAS float* EGa = (const LAS float*)(B + GC_EG); const LAS float* BSa = (const LAS float*)(B + GC_BS);
        const f32x4 eg4 = *(const LAS f32x4*)(EGa + 4 * fq), be4 = *(const LAS f32x4*)(BSa + 4 * fq);
        const float egl = EGa[15];
        u32x4 af; { const u32x2 t = *(const LAS u32x2*)(B + GC_AQ + fr * 32 + 8 * fq); af.x = t.x; af.y = t.y; af.z = 0u; af.w = 0u; }
        u32x4 tf; { const u32x2 t = *(const LAS u32x2*)(B + GC_TT + fr * 32 + 8 * fq); tf.x = t.x; tf.y = t.y; tf.z = 0u; tf.w = 0u; }
        f32x4 P = (f32x4){0.f, 0.f, 0.f, 0.f}, QS = P;
#pragma unroll
        for (int ks = 0; ks < 4; ++ks) {
            const u32x2 ka = *(const LAS u32x2*)(B + GC_KT + fr * 272 + 64 * ks + 8 * fq), kb = *(const LAS u32x2*)(B + GC_KT + fr * 272 + 64 * ks + 32 + 8 * fq);
            const u32x2 qa = *(const LAS u32x2*)(B + GC_QT + fr * 272 + 64 * ks + 8 * fq), qb = *(const LAS u32x2*)(B + GC_QT + fr * 272 + 64 * ks + 32 + 8 * fq);
            u32x4 k2; k2.x = ka.x; k2.y = ka.y; k2.z = kb.x; k2.w = kb.y; u32x4 q2; q2.x = qa.x; q2.y = qa.y; q2.z = qb.x; q2.w = qb.y;
            u32x4 sf; sf.x = pk2(acc[2 * ks][0], acc[2 * ks][1]); sf.y = pk2(acc[2 * ks][2], acc[2 * ks][3]); sf.z = pk2(acc[2 * ks + 1][0], acc[2 * ks + 1][1]); sf.w = pk2(acc[2 * ks + 1][2], acc[2 * ks + 1][3]);
            P = __builtin_amdgcn_mfma_f32_16x16x32_bf16(__builtin_bit_cast(bf16x8, k2), __builtin_bit_cast(bf16x8, sf), P, 0, 0, 0);
            QS = __builtin_amdgcn_mfma_f32_16x16x32_bf16(__builtin_bit_cast(bf16x8, q2), __builtin_bit_cast(bf16x8, sf), QS, 0, 0, 0); }
        float Rr[4];
#pragma unroll
        for (int jj = 0; jj < 4; ++jj) { const float vv = ((const LAS float*)(B + GC_V))[(4 * fq + jj) * 128 + 16 * w + fr]; Rr[jj] = be4[jj] * (vv - eg4[jj] * P[jj]); }
        u32x4 rf; rf.x = pk2(Rr[0], Rr[1]); rf.y = pk2(Rr[2], Rr[3]); rf.z = 0u; rf.w = 0u;
        const f32x4 vn = __builtin_amdgcn_mfma_f32_16x16x32_bf16(__builtin_bit_cast(bf16x8, tf), __builtin_bit_cast(bf16x8, rf), (f32x4){0.f, 0.f, 0.f, 0.f}, 0, 0, 0);
        u32x4 vf; vf.x = pk2(vn[0], vn[1]); vf.y = pk2(vn[2], vn[3]); vf.z = 0u; vf.w = 0u;
        const f32x4 oi = __builtin_amdgcn_mfma_f32_16x16x32_bf16(__builtin_bit_cast(bf16x8, af), __builtin_bit_cast(bf16x8, vf), (f32x4){0.f, 0.f, 0.f, 0.f}, 0, 0, 0);
#pragma unroll
        for (int jj = 0; jj < 4; jj += 2) { const unsigned op = pk2(eg4[jj] * QS[jj] + oi[jj], eg4[jj + 1] * QS[jj + 1] + oi[jj + 1]);
            OS[(size_t)GC_ROW(c, 4 * fq + jj) * 1024 + h * 128 + 16 * w + fr] = (bf16_t)(op & 0xffffu); OS[(size_t)GC_ROW(c, 4 * fq + jj + 1) * 1024 + h * 128 + 16 * w + fr] = (bf16_t)(op >> 16); }
#pragma unroll
        for (int dt = 0; dt < 8; ++dt) {
            u32x4 kdf; { const u32x2 t = *(const LAS u32x2*)(B + GC_KD + (16 * dt + fr) * 80 + 8 * fq); kdf.x = t.x; kdf.y = t.y; kdf.z = 0u; kdf.w = 0u; }
            acc[dt] = __builtin_amdgcn_mfma_f32_16x16x32_bf16(__builtin_bit_cast(bf16x8, kdf), __builtin_bit_cast(bf16x8, vf), acc[dt] * egl, 0, 0, 0); }
        }
        LDS_BARRIER();
    }
#undef GC_ROW
#undef GC_PREFETCH
#undef GC_TSTAGE
    if (s < 16) { float* so = a.out + OUT_SGDN + ((((size_t)s * 2 + l) * 2 + dir) * 8 + h) * 16384;
#pragma unroll
        for (int dt = 0; dt < 8; ++dt)
#pragma unroll
            for (int jj = 0; jj < 4; ++jj) so[(16 * dt + 4 * fq + jj) * 128 + 16 * w + fr] = acc[dt][jj]; }
    __syncthreads();
}

__device__ __forceinline__ void gmlp_item(KArgs& a, LAS unsigned char* lds, int l, int chunk, int g) {
    const int tid = otid(), lane = tid & 63, w = tid >> 6, row0 = chunk * 128;
    LAS bf16_t* vT = (LAS bf16_t*)lds;
    { const int q = tid >> 2, part = tid & 3;
      const bf16_t* src = (const bf16_t*)(a.ws + WS_CV) + (size_t)(row0 + q) * 1024 + g * 128 + part * 32;
      float x[32]; float ss = 0.f;
#pragma unroll
      for (int i = 0; i < 4; ++i) { const u32x4 r = ((const u32x4*)src)[i];
          x[8 * i] = bf_lo(r.x); x[8 * i + 1] = bf_hi(r.x); x[8 * i + 2] = bf_lo(r.y); x[8 * i + 3] = bf_hi(r.y); x[8 * i + 4] = bf_lo(r.z); x[8 * i + 5] = bf_hi(r.z); x[8 * i + 6] = bf_lo(r.w); x[8 * i + 7] = bf_hi(r.w); }
#pragma unroll
      for (int i = 0; i < 32; ++i) ss += x[i] * x[i];
      ss += __shfl_xor(ss, 1); ss += __shfl_xor(ss, 2);
      const float rstd = rsqrtf(ss * (1.0f / 128.0f) + EPS);
      const float* gn = a.in[13] + l * 1024 + g * 128 + part * 32;
#pragma unroll
      for (int i = 0; i < 32; ++i) vT[(part * 32 + i) * 136 + q] = (bf16_t)f2bf(x[i] * rstd * gn[i]);
    }
    __syncthreads();
    const int fr = lane & 15, fq = lane >> 4, p = 16 * w + fr;
    const float* wsrow = a.in[14] + (((size_t)l * 8 + g) * 128 + p) * 128;
    bf16x8 bw[4];
#pragma unroll
    for (int ks = 0; ks < 4; ++ks) { const f32x4 x0 = *(const f32x4*)(wsrow + ks * 32 + 8 * fq), x1 = *(const f32x4*)(wsrow + ks * 32 + 8 * fq + 4);
        u32x4 t; t.x = pk2(x0.x, x0.y); t.y = pk2(x0.z, x0.w); t.z = pk2(x1.x, x1.y); t.w = pk2(x1.z, x1.w); bw[ks] = __builtin_bit_cast(bf16x8, t); }
    const float bias = a.in[15][((size_t)l * 8 + g) * 128 + p];
    const bf16_t* CU = (const bf16_t*)(a.ws + WS_CU); bf16_t* OB = (bf16_t*)(a.ws + WS_OB);
#pragma unroll
    for (int ct = 0; ct < 8; ++ct) {
        f32x4 acc = (f32x4){0.f, 0.f, 0.f, 0.f};
#pragma unroll
        for (int ks = 0; ks < 4; ++ks) { const bf16x8 av = *(const LAS bf16x8*)(vT + (ct * 16 + fr) * 136 + ks * 32 + 8 * fq);
            acc = __builtin_amdgcn_mfma_f32_16x16x32_bf16(av, bw[ks], acc, 0, 0, 0); }
        const size_t o = (size_t)(row0 + p) * 1024 + g * 128 + ct * 16 + 4 * fq;
        const u32x2 uu = *(const u32x2*)(CU + o);
        u32x2 r; r.x = pk2(bf_lo(uu.x) * (acc[0] + bias), bf_hi(uu.x) * (acc[1] + bias)); r.y = pk2(bf_lo(uu.y) * (acc[2] + bias), bf_hi(uu.y) * (acc[3] + bias));
        *(u32x2*)(OB + o) = r;
    }
    __syncthreads();
}

__device__ __forceinline__ void phase_mixers(KArgs& a, LAS unsigned char* lds, int lq) {
    const int l = lq & 1;
    unsigned* head = (unsigned*)(a.ws + WS_CTL) + CW_QUEUE + 64 * lq;
    volatile LAS unsigned* slot = (volatile LAS unsigned*)(lds + LDS_MISC);
    bool seeded = false;
    for (;;) {
        int idx;
        if (!seeded) { idx = (int)blockIdx.x; seeded = true; }
        else {
            if (otid() == 0) slot[0] = __hip_atomic_fetch_add(head, 1u, __ATOMIC_RELAXED, __HIP_MEMORY_SCOPE_AGENT);
            __syncthreads();
            idx = (int)gridDim.x + (int)slot[0];
            __syncthreads();
        }
        {
            const int nsup = l ? BG1_SUPER : BG0_SUPER;
            if (idx >= 1152 + nsup) break;
            if (idx >= 128) { const int r = idx - 128;
                if (r < 2 * nsup) { if (r & 1) { conv_super_item(a, lds, l ? BG1_FIRST : BG0_FIRST, l ? BG1_END : BG0_END, r >> 1); continue; } idx = 128 + (r >> 1); }
                else idx = 128 + nsup + (r - 2 * nsup); }
        }
        if (idx < 640) {
            const bool lat = idx < 128; const int j = lat ? idx : idx - 128; const bool gdn = lat ? (j < 64) : (j < 256);
            const int jj = lat ? (j & 63) : (gdn ? j : j - 256); const int s = lat ? 16 + (jj >> 4) : (jj >> 4); const int rem = jj & 15;
            if (gdn) gdn_chunk_item(a, lds, l, s, rem >> 1, rem & 1); else hgrn_chunk_item(a, lds, l, s, rem >> 1, rem & 1);
        } else { const int j = idx - 640; gmlp_item(a, lds, l, j >> 3, j & 7); }
    }
}

__device__ __forceinline__ void phase_onorm(KArgs& a, int l) {
    const int tid = otid(), lane = tid & 63, wave = tid >> 6, gw = blockIdx.x * 8 + wave, NGW = gridDim.x * 8;
    const int sub = lane >> 4, l16 = lane & 15;
    for (int it = gw * 4 + sub; it < NTOK * 16; it += NGW * 4) {
        const int br = it & 1, rh = it >> 1, r = rh >> 3, h = rh & 7;
        const bf16_t* OS = (const bf16_t*)(a.ws + (br ? WS_OSG : WS_OSH)); const size_t o = (size_t)r * 1024 + h * 128 + 8 * l16;
        const u32x4 w0 = *(const u32x4*)(OS + o), w1 = *(const u32x4*)(OS + (size_t)NTOK * 1024 + o);
        const u32x4 gg = *(const u32x4*)((const bf16_t*)(a.ws + (br ? WS_GGO : WS_HGO)) + o);
        const float* gnp = a.in[br ? 19 : 12] + l * 128 + 8 * l16; const f32x4 g0 = *(const f32x4*)gnp, g1 = *(const f32x4*)(gnp + 4);
        float y[8] = {bf_lo(w0.x) + bf_lo(w1.x), bf_hi(w0.x) + bf_hi(w1.x), bf_lo(w0.y) + bf_lo(w1.y), bf_hi(w0.y) + bf_hi(w1.y),
                      bf_lo(w0.z) + bf_lo(w1.z), bf_hi(w0.z) + bf_hi(w1.z), bf_lo(w0.w) + bf_lo(w1.w), bf_hi(w0.w) + bf_hi(w1.w)};
        float ss = 0.f;
#pragma unroll
        for (int e = 0; e < 8; ++e) ss += y[e] * y[e];
        const float rstd = rsqrtf(red16(ss) * (1.0f / 128.0f) + EPS);
        u32x4 out;
        out.x = pk2(y[0] * rstd * g0.x * bf_lo(gg.x), y[1] * rstd * g0.y * bf_hi(gg.x)); out.y = pk2(y[2] * rstd * g0.z * bf_lo(gg.y), y[3] * rstd * g0.w * bf_hi(gg.y));
        out.z = pk2(y[4] * rstd * g1.x * bf_lo(gg.z), y[5] * rstd * g1.y * bf_hi(gg.z)); out.w = pk2(y[6] * rstd * g1.z * bf_lo(gg.w), y[7] * rstd * g1.w * bf_hi(gg.w));
        *(u32x4*)((bf16_t*)(a.ws + (br ? WS_OC : WS_OA)) + o) = out;
    }
}

#define XB_TMO      128
#define XB_XCNT(j)  (256  + 64 * (j))
#define XB_XSUB(j)  (1280 + 64 * (j))
#define XB_XGEN(j)  (2304 + 64 * (j))
#define XB_TOP      3328
#define XB_TOPGEN   3392
#define XCD_BAR_WORDS 3456
#define XB_SPIN_CAP (1u << 18)

__device__ __forceinline__ unsigned xb_ld(unsigned* p)              { return __hip_atomic_load(p, __ATOMIC_RELAXED, __HIP_MEMORY_SCOPE_AGENT); }
__device__ __forceinline__ unsigned xb_add(unsigned* p, unsigned v) { return __hip_atomic_fetch_add(p, v, __ATOMIC_RELAXED, __HIP_MEMORY_SCOPE_AGENT); }
__device__ __forceinline__ unsigned xb_xcc_id() { return (unsigned)__builtin_amdgcn_s_getreg((3 << 11) | 20) & 0xFu; }
#define XB_SPIN(cond, bar) do { unsigned _sp = 0; while (cond) { __builtin_amdgcn_s_sleep(1); \
    if ((++_sp & 255u) == 0u) { if (xb_ld(&(bar)[XB_TMO])) break; if (_sp > XB_SPIN_CAP) { atomicAdd(&(bar)[XB_TMO], 1u); break; } } } } while (0)

struct XcdBarrier {
    unsigned* bar; unsigned x;
    volatile LAS unsigned* st;
};

__device__ __forceinline__ XcdBarrier xcd_barrier_post(unsigned* bar, volatile LAS unsigned* st) {
    XcdBarrier b; b.bar = bar; b.x = xb_xcc_id(); b.st = st;
    if (threadIdx.x == 0) (void)xb_add(&bar[XB_XCNT(b.x)], 1u);
    return b;
}
__device__ __forceinline__ void xcd_barrier_complete(unsigned* bar, unsigned x, unsigned& nloc, unsigned& nx) {
    const unsigned G = gridDim.x * gridDim.y * gridDim.z;
    unsigned sum, cnt, mine, sp = 0u;
    for (;;) {
        sum = 0u; cnt = 0u; mine = 0u;
#pragma unroll
        for (unsigned j = 0; j < 16; ++j) { const unsigned c = xb_ld(&bar[XB_XCNT(j)]); sum += c; cnt += (c > 0u) ? 1u : 0u; mine = (j == x) ? c : mine; }
        if (sum == G) break;
        __builtin_amdgcn_s_sleep(1);
        if ((++sp & 255u) == 0u) { if (xb_ld(&bar[XB_TMO])) break; if (sp > XB_SPIN_CAP) { atomicAdd(&bar[XB_TMO], 1u); break; } }
    }
    nloc = mine > 0u ? mine : 1u; nx = cnt > 0u ? cnt : 1u;
}

__device__ __forceinline__ void xcd_barrier(const XcdBarrier& b) {
    asm volatile("s_waitcnt vmcnt(0)" ::: "memory");
    __syncthreads();
    if (threadIdx.x == 0) {
        unsigned* bar = b.bar;
        __builtin_amdgcn_s_waitcnt(0);
        unsigned nloc = b.st[0], nx = b.st[1];
        if (nloc == 0u) { xcd_barrier_complete(bar, b.x, nloc, nx); b.st[0] = nloc; b.st[1] = nx; }
        const unsigned old = xb_add(&bar[XB_XSUB(b.x)], 1u);
        const unsigned gen = old / nloc;
        if (old + 1u == (gen + 1u) * nloc) {
            __builtin_amdgcn_fence(__ATOMIC_RELEASE, "agent");
            asm volatile("s_waitcnt vmcnt(0)" ::: "memory");
            const unsigned og = xb_add(&bar[XB_TOP], 1u);
            const unsigned tg = og / nx;
            if (og + 1u == (tg + 1u) * nx) xb_add(&bar[XB_TOPGEN], 1u);
            else XB_SPIN(xb_ld(&bar[XB_TOPGEN]) == tg, bar);
            __builtin_amdgcn_fence(__ATOMIC_ACQUIRE, "agent");
            xb_add(&bar[XB_XGEN(b.x)], 1u);
            asm volatile("s_waitcnt vmcnt(0)" ::: "memory");
        } else {
            XB_SPIN(xb_ld(&bar[XB_XGEN(b.x)]) == gen, bar);
            __builtin_amdgcn_fence(__ATOMIC_ACQUIRE, "agent");
            asm volatile("s_waitcnt vmcnt(0)" ::: "memory");
        }
    }
    __syncthreads();
}


__device__ __forceinline__ void run_phase(LAS unsigned char* lds, int ph, int rep) {
    KArgs& a = *get_args();
#ifndef DIAG_ONLY
    if (ph == 0) { phase_prologue(a, lds); return; }
    if (ph == 21) { phase_final_norm(a); return; }
#else
    if (ph == 0 || ph == 21) { if (DIAG_ONLY == 10) phase_prologue(a, lds); return; }
#endif
    const int l = (ph - 1) / 10, k = (ph - 1) % 10;
    unsigned char* wl = a.ws + WS_W + (size_t)l * W_LSTRIDE;
    const int G = gridDim.x, c = blockIdx.x;
#ifdef DIAG_ONLY
    if (k != DIAG_ONLY) return;
#endif
    switch (k) {
    case 0: phase_norm_mod(a, l, 0); break;
    case 1: { pg8::Gemm g{(const bf16_t*)(a.ws + WS_H), (const bf16_t*)(wl + W_IN), NTOK, IN_PAD, D}; pg8::StaticOrder S; S.init(NTOK, IN_PAD, G, c);
              EpiIn E{a.ws, a.in[11], a.in[17], a.in[18], l}; pg8::gemm_phase<EpiIn, pg8::StaticOrder, true, true>(lds, g, S, E); } break;
    case 2: phase_gdn_prep(a, l); break;
    case 3: phase_mixers(a, lds, l + 2 * rep); break;
    case 4: phase_onorm(a, l); break;
    case 5: { pg8::Gemm g{(const bf16_t*)(a.ws + WS_OA), (const bf16_t*)(wl + W_BR), 3 * NTOK, 3 * D, 1024};
              Br3Order S; S.base.init(NTOK, D, G, c); EpiBr3 E{a.ws}; pg8::gemm_phase<EpiBr3, Br3Order, true, true>(lds, g, S, E); } break;
    case 6: { pg8::Gemm g{(const bf16_t*)(a.ws + WS_MERGED), (const bf16_t*)(wl + W_OUT), NTOK, D, D}; pg8::StaticOrder S; S.init(NTOK, D, G, c);
              EpiRes E{a.ws, l, 4096}; pg8::gemm_phase<EpiRes, pg8::StaticOrder, true, true>(lds, g, S, E); } break;
    case 7: phase_norm_mod(a, l, 1); break;
    case 8: { pg8::Gemm g{(const bf16_t*)(a.ws + WS_H), (const bf16_t*)(wl + W_FF1), NTOK, DFF, D}; pg8::StaticOrder S; S.init(NTOK, DFF, G, c);
              EpiRelu2 E{a.ws}; pg8::gemm_phase<EpiRelu2, pg8::StaticOrder, true, true>(lds, g, S, E); } break;
    case 9: { pg8::Gemm g{(const bf16_t*)(a.ws + WS_FFH), (const bf16_t*)(wl + W_FF2), NTOK, D, DFF}; pg8::StaticOrder S; S.init(NTOK, D, G, c);
              EpiRes E{a.ws, l, 10240}; pg8::gemm_phase<EpiRes, pg8::StaticOrder, true, true>(lds, g, S, E); } break;
    }
}

#ifndef PROBE_REPEAT_K
#define PROBE_REPEAT_K (-1)
#endif
__global__ void __launch_bounds__(NTHR, 2) fwd_megakernel(Args args) {
    extern __shared__ __attribute__((aligned(16))) unsigned char lds_raw[];
    LAS unsigned char* lds = (LAS unsigned char*)lds_raw;
#if MK_MULTI
    for (int ph = args.ph_lo; ph < args.ph_hi; ++ph) { run_phase(lds, ph, 0); __syncthreads(); }
#else
    cg::grid_group grid = cg::this_grid();
    volatile LAS unsigned* misc = (volatile LAS unsigned*)(lds + LDS_MISC);
    if (threadIdx.x < 16) misc[threadIdx.x] = 0u;
    __syncthreads();
    XcdBarrier bar = xcd_barrier_post((unsigned*)(args.ws + WS_CTL) + CW_BAR, misc + 8);
    grid.sync();
#pragma unroll 1
    for (int ph = args.ph_lo; ph < args.ph_hi; ++ph) {
        run_phase(lds, ph, 0);
        if (PROBE_REPEAT_K != -1 && ((PROBE_REPEAT_K == -2 && ph == 0) || (ph >= 1 && ph <= 20 && (ph - 1) % 10 == PROBE_REPEAT_K))) { xcd_barrier(bar); run_phase(lds, ph, 1); }
        if (ph + 1 < args.ph_hi) {
            xcd_barrier(bar);
        }
    }
#endif
}

extern "C" void kernel_launch(void* const* d_in, const int* in_sizes, int n_in, void* d_out, int out_size, void* d_ws, size_t ws_size, hipStream_t stream) {
    static int grid = 0;
    if (grid == 0) {
        int dev = 0, cus = 0, per_cu = 0;
        if (n_in != 27 || ws_size < WS_END) { fprintf(stderr, "kernel_launch: unexpected n_in %d or ws_size %zu (< %zu)\n", n_in, ws_size, (size_t)WS_END); grid = -1; return; }
        if (hipGetDevice(&dev) != hipSuccess || hipDeviceGetAttribute(&cus, hipDeviceAttributeMultiprocessorCount, dev) != hipSuccess) { grid = -1; return; }
        if (hipFuncSetAttribute((const void*)fwd_megakernel, hipFuncAttributeMaxDynamicSharedMemorySize, LDS_BYTES) != hipSuccess) { fprintf(stderr, "kernel_launch: hipFuncSetAttribute failed\n"); grid = -1; return; }
        if (hipOccupancyMaxActiveBlocksPerMultiprocessor(&per_cu, (const void*)fwd_megakernel, NTHR, LDS_BYTES) != hipSuccess || per_cu < 1) { fprintf(stderr, "kernel_launch: occupancy query failed (%d)\n", per_cu); (void)hipGetLastError(); per_cu = 1; }
        grid = cus * per_cu;
    }
    if (grid < 0) return;
    (void)hipMemsetAsync((char*)d_ws + WS_CTL, 0, CTL_BYTES, stream);
    Args a{};
    for (int i = 0; i < 27; ++i) a.in[i] = (const float*)d_in[i];
    a.out = (float*)d_out; a.ws = (unsigned char*)d_ws;
#if MK_MULTI
    for (int ph = 0; ph < N_PHASES; ++ph) { a.ph_lo = ph; a.ph_hi = ph + 1; hipLaunchKernelGGL(fwd_megakernel, dim3(grid), dim3(NTHR), LDS_BYTES, stream, a); }
#else
    a.ph_lo = 0; a.ph_hi = N_PHASES;
    void* kargs[] = {(void*)&a};
    hipError_t e = hipLaunchCooperativeKernel((const void*)fwd_megakernel, dim3(grid), dim3(NTHR), kargs, LDS_BYTES, stream);
    if (e != hipSuccess) fprintf(stderr, "kernel_launch: cooperative launch failed: %s (grid %d)\n", hipGetErrorString(e), grid);
#endif
}
```

```cpp
#include <hip/hip_runtime.h>
#include <hip/hip_cooperative_groups.h>
#include <cstdio>
#include <cstdint>
namespace cg = cooperative_groups;
namespace pg8 {
#define PG8_LAS __attribute__((address_space(3)))
typedef unsigned short bf16_t;
typedef short bf16x8 __attribute__((ext_vector_type(8)));
typedef float f32x4 __attribute__((ext_vector_type(4)));
typedef unsigned u32x4 __attribute__((ext_vector_type(4)));
constexpr int BM = 256, BK = 64, HALF = 128, HTB = HALF * BK * 2  , STAGE_BYTES = 8 * HTB, NXCD = 8, WGM = 8;

__host__ __device__ __forceinline__ int lds_byte(int r, int c) { const int st = (r >> 4) * 2 + (c >> 5), rr = r & 15, cc = c & 31, ob = rr * 64 + cc * 2; return st * 1024 + (ob ^ (((ob >> 9) & 1) << 5)); }
__host__ __device__ __forceinline__ void stage_rc(int b, int& R, int& C) { const int st = b / 1024, sb = b % 1024, swz = sb ^ (((sb >> 9) & 1) << 5); R = (st >> 1) * 16 + swz / 64; C = (st & 1) * 32 + (swz % 64) / 2; }
__host__ __device__ __forceinline__ int perm32(int rho) { const int n = rho >> 4, i = rho & 15; return 8 * (i >> 2) + 4 * n + (i & 3); }

struct Unit { int pm, pn; };
struct Gemm { const bf16_t* A; const bf16_t* Bt; int M, N, K; };

struct StaticOrder {
    int nM, nN, nwg, G, c;
    __host__ __device__ void init(int M, int N, int G_, int c_) { nM = M / BM; nN = N / BM; nwg = nM * nN; G = G_; c = c_; }
    __host__ __device__ bool next(int i, Unit& u) const {
        const long L = (long)i * G + c; if (L >= nwg) return false;
        int wgid = (int)L; { const int q = nwg / NXCD, r = nwg % NXCD, xcd = wgid % NXCD, off = wgid / NXCD; wgid = (xcd < r ? xcd * (q + 1) : r * (q + 1) + (xcd - r) * q) + off; }
        const int nig = WGM * nN, gid = wgid / nig, fm = gid * WGM, gsz = (nM - fm) < WGM ? (nM - fm) : WGM;
        u.pm = fm + ((wgid % nig) % gsz); u.pn = (wgid % nig) / gsz; return true;
    }
    __device__ __forceinline__ void a_ready(const Unit&) const {}
    __device__ __forceinline__ void done(const Unit&) const {}
};

__device__ __forceinline__ unsigned cvt_pk_bf16(float lo, float hi) { unsigned r; asm volatile("v_cvt_pk_bf16_f32 %0, %1, %2" : "=v"(r) : "v"(lo), "v"(hi)); return r; }
template <class Epi, class Sched, bool ALIGN_EPI = false, bool SP2 = false>
__device__ __forceinline__ void gemm_phase(PG8_LAS unsigned char* lds, const Gemm g, const Sched& S, const Epi& E) {
    int tid_o = threadIdx.x; asm volatile("" : "+v"(tid_o)); const int tid = tid_o, wid = __builtin_amdgcn_readfirstlane(tid >> 6), lane = tid & 63, wr = wid >> 2, wc = wid & 3, fr = lane & 15, fq = lane >> 4;
    const int K = g.K, nt = K / BK;
    unsigned voffA[2], voffB[2];
#pragma unroll
    for (int i = 0; i < 2; ++i) { int R, C; stage_rc(tid * 16 + i * 8192, R, C); const int Rb = Epi::PERM ? ((R & ~31) + perm32(R & 31)) : R;
        voffA[i] = (unsigned)(R * K + C) * 2u; voffB[i] = (unsigned)(Rb * K + C) * 2u; }
    const size_t kstep = (size_t)(BK * 2);
    const size_t hstep = (size_t)HALF * K * 2;
    const size_t tstep = 2 * hstep;
    const unsigned ldsw = (unsigned)wid * 1024u;
    const int aoff = lds_byte(wr * 64 + fr, fq * 8), boff = lds_byte(wc * 32 + fr, fq * 8);
#define PG8_SA(b, h) (((b) * 2 + (h)) * HTB)
#define PG8_SB(b, h) ((4 + (b) * 2 + (h)) * HTB)
#define PG8_STAGE(bufoff, gbase, voff) do { _Pragma("unroll") for (int _i = 0; _i < 2; ++_i) \
        __builtin_amdgcn_global_load_lds((const unsigned*)((const char*)(gbase) + (voff)[_i]), (PG8_LAS unsigned*)(lds + (bufoff) + ldsw + _i * 8192), 16, 0, 0); } while (0)
#define PG8_LDA(dst, b, h) do { _Pragma("unroll") for (int m = 0; m < 4; ++m) _Pragma("unroll") for (int k = 0; k < 2; ++k) dst[m][k] = *(const PG8_LAS bf16x8*)(lds + PG8_SA(b, h) + aoff + m * 2048 + k * 1024); } while (0)
#define PG8_LDB(dst, b, h) do { _Pragma("unroll") for (int n = 0; n < 2; ++n) _Pragma("unroll") for (int k = 0; k < 2; ++k) dst[n][k] = *(const PG8_LAS bf16x8*)(lds + PG8_SB(b, h) + boff + n * 2048 + k * 1024); } while (0)
#define PG8_MMA(ai, bj, At, Bt) do { __builtin_amdgcn_s_setprio(1); _Pragma("unroll") for (int m = 0; m < 4; ++m) _Pragma("unroll") for (int n = 0; n < 2; ++n) _Pragma("unroll") for (int k = 0; k < 2; ++k) \
        acc[ai][bj][m][n] = __builtin_amdgcn_mfma_f32_16x16x32_bf16(Bt[n][k], At[m][k], acc[ai][bj][m][n], 0, 0, 0); __builtin_amdgcn_s_setprio(0); } while (0)
#define PG8_WAIT_V(n) asm volatile("s_waitcnt vmcnt(" #n ")" ::: "memory")
#define PG8_WAIT_L(n) asm volatile("s_waitcnt lgkmcnt(" #n ")" ::: "memory")
#define PG8_BAR __builtin_amdgcn_s_barrier()
#define PG8_SCHED __builtin_amdgcn_sched_barrier(0)
    Unit cur, nxt; int ui = 0;
    if (!S.next(0, cur)) return;
    f32x4 acc[2][2][4][2];
#pragma unroll
    for (int a = 0; a < 2; ++a)
#pragma unroll
        for (int b = 0; b < 2; ++b)
#pragma unroll
            for (int m = 0; m < 4; ++m)
#pragma unroll
                for (int n = 0; n < 2; ++n) acc[a][b][m][n] = (f32x4){0.f, 0.f, 0.f, 0.f};
    bf16x8 At[4][2], B0[2][2], B1[2][2];
    const char* cA = (const char*)g.A + (size_t)cur.pm * tstep; const char* cB = (const char*)g.Bt + (size_t)cur.pn * tstep;
    S.a_ready(cur);
    if constexpr (SP2) {
        PG8_STAGE(PG8_SB(0, 0), cB, voffB); PG8_STAGE(PG8_SB(0, 1), cB + hstep, voffB); PG8_STAGE(PG8_SA(0, 0), cA, voffA); PG8_STAGE(PG8_SA(0, 1), cA + hstep, voffA);
        if (wr == 1) PG8_BAR;
        PG8_WAIT_V(2); PG8_BAR;
        PG8_STAGE(PG8_SB(1, 0), cB + kstep, voffB); PG8_STAGE(PG8_SA(1, 0), cA + kstep, voffA); PG8_STAGE(PG8_SB(1, 1), cB + hstep + kstep, voffB);
        PG8_WAIT_V(6); PG8_BAR;
    } else {
        PG8_STAGE(PG8_SB(0, 0), cB, voffB); PG8_STAGE(PG8_SA(0, 0), cA, voffA); PG8_STAGE(PG8_SB(0, 1), cB + hstep, voffB); PG8_STAGE(PG8_SA(0, 1), cA + hstep, voffA);
        if (wr == 1) PG8_BAR;
        PG8_WAIT_V(4); PG8_BAR;
        PG8_STAGE(PG8_SB(1, 0), cB + kstep, voffB); PG8_STAGE(PG8_SA(1, 0), cA + kstep, voffA); PG8_STAGE(PG8_SB(1, 1), cB + hstep + kstep, voffB);
        PG8_WAIT_V(6); PG8_BAR;
    }
    for (;;) {
        const bool has_next = S.next(ui + 1, nxt);
        const char* nA = has_next ? (const char*)g.A + (size_t)nxt.pm * tstep : cA; const char* nB = has_next ? (const char*)g.Bt + (size_t)nxt.pn * tstep : cB;
        for (int t = 0; t < nt; t += 2) {
            const bool last = (t == nt - 2);
            const char* a1 = cA + (size_t)(t + 1) * kstep;
            const char* a2 = last ? nA : cA + (size_t)(t + 2) * kstep; const char* b2 = last ? nB : cB + (size_t)(t + 2) * kstep;
            const char* a3 = a2 + kstep; const char* b3 = b2 + kstep;
            if (last && has_next) S.a_ready(nxt);
            if constexpr (SP2) {
            PG8_LDB(B0, 0, 0); PG8_LDB(B1, 0, 1); PG8_SCHED; PG8_LDA(At, 0, 0); PG8_STAGE(PG8_SA(1, 1), a1 + hstep, voffA);
            PG8_WAIT_V(8); PG8_WAIT_L(0); PG8_BAR; PG8_MMA(0, 0, At, B0); PG8_MMA(0, 1, At, B1); PG8_BAR; PG8_SCHED;
            PG8_LDA(At, 0, 1); PG8_STAGE(PG8_SB(0, 0), b2, voffB); PG8_STAGE(PG8_SB(0, 1), b2 + hstep, voffB); PG8_STAGE(PG8_SA(0, 0), a2, voffA);
            PG8_WAIT_V(8); PG8_WAIT_L(0); PG8_BAR; PG8_MMA(1, 0, At, B0); PG8_MMA(1, 1, At, B1); PG8_BAR; PG8_SCHED;
            PG8_LDB(B0, 1, 0); PG8_LDB(B1, 1, 1); PG8_SCHED; PG8_LDA(At, 1, 0); PG8_STAGE(PG8_SA(0, 1), a2 + hstep, voffA);
            PG8_WAIT_V(8); PG8_WAIT_L(0); PG8_BAR; PG8_MMA(0, 0, At, B0); PG8_MMA(0, 1, At, B1); PG8_BAR; PG8_SCHED;
            PG8_LDA(At, 1, 1); PG8_STAGE(PG8_SB(1, 0), b3, voffB); PG8_STAGE(PG8_SB(1, 1), b3 + hstep, voffB); PG8_STAGE(PG8_SA(1, 0), a3, voffA);
            PG8_WAIT_V(8); PG8_WAIT_L(0); PG8_BAR; PG8_MMA(1, 0, At, B0); PG8_MMA(1, 1, At, B1); PG8_BAR; PG8_SCHED;
            } else {
            PG8_LDB(B0, 0, 0); PG8_SCHED; PG8_LDA(At, 0, 0); PG8_STAGE(PG8_SA(1, 1), a1 + hstep, voffA);
            PG8_WAIT_L(8); PG8_BAR; PG8_WAIT_L(0); PG8_MMA(0, 0, At, B0); PG8_BAR; PG8_SCHED;
            PG8_LDB(B1, 0, 1); PG8_STAGE(PG8_SB(0, 0), b2, voffB);
            PG8_BAR; PG8_WAIT_L(0); PG8_MMA(0, 1, At, B1); PG8_BAR;
            PG8_LDA(At, 0, 1); PG8_STAGE(PG8_SA(0, 0), a2, voffA);
            PG8_BAR; PG8_WAIT_L(0); PG8_MMA(1, 0, At, B0); PG8_BAR; PG8_SCHED;
            PG8_STAGE(PG8_SB(0, 1), b2 + hstep, voffB);
            PG8_WAIT_V(6); PG8_BAR; PG8_MMA(1, 1, At, B1); PG8_BAR;
            PG8_LDB(B0, 1, 0); PG8_SCHED; PG8_LDA(At, 1, 0); PG8_STAGE(PG8_SA(0, 1), a2 + hstep, voffA);
            PG8_WAIT_L(8); PG8_BAR; PG8_WAIT_L(0); PG8_MMA(0, 0, At, B0); PG8_BAR; PG8_SCHED;
            PG8_LDB(B1, 1, 1); PG8_STAGE(PG8_SB(1, 0), b3, voffB);
            PG8_BAR; PG8_WAIT_L(0); PG8_MMA(0, 1, At, B1); PG8_BAR;
            PG8_LDA(At, 1, 1); PG8_STAGE(PG8_SA(1, 0), a3, voffA);
            PG8_BAR; PG8_WAIT_L(0); PG8_MMA(1, 0, At, B0); PG8_BAR; PG8_SCHED;
            PG8_STAGE(PG8_SB(1, 1), b3 + hstep, voffB);
            PG8_WAIT_V(6); PG8_BAR; PG8_MMA(1, 1, At, B1); PG8_BAR;
            }
        }
        if constexpr (ALIGN_EPI) { if (wr == 0) PG8_BAR; }
        bool keep_acc = false;
        if constexpr (!Epi::AFTER_DRAIN) { E(acc, cur, wr, wc, fr, fq); if constexpr (Epi::KEEP) keep_acc = E.keep(cur); S.done(cur); }
        if (!has_next) break;
        if (!keep_acc)
#pragma unroll
        for (int a = 0; a < 2; ++a)
#pragma unroll
            for (int b = 0; b < 2; ++b)
#pragma unroll
                for (int m = 0; m < 4; ++m)
#pragma unroll
                    for (int n = 0; n < 2; ++n) acc[a][b][m][n] = (f32x4){0.f, 0.f, 0.f, 0.f};
        cur = nxt; cA = nA; cB = nB; ++ui;
        if constexpr (ALIGN_EPI) { if (wr == 1) PG8_BAR; }
    }
    PG8_WAIT_V(0);
    if constexpr (!ALIGN_EPI) { if (wr == 0) PG8_BAR; }
    PG8_BAR;
    if constexpr (Epi::AFTER_DRAIN) { E.fused(acc, cur, wr, wc, fr, fq, lds, wid, lane); S.done(cur); }
#undef PG8_SA
#undef PG8_SB
#undef PG8_STAGE
#undef PG8_LDA
#undef PG8_LDB
#undef PG8_MMA
#undef PG8_WAIT_V
#undef PG8_WAIT_L
#undef PG8_BAR
#undef PG8_SCHED
}
}


#ifndef MK_MULTI
#define MK_MULTI 0
#endif
#define LAS __attribute__((address_space(3)))
typedef unsigned short bf16_t;
typedef float f32x4 __attribute__((ext_vector_type(4)));
typedef float f32x2 __attribute__((ext_vector_type(2)));
typedef unsigned u32x4 __attribute__((ext_vector_type(4)));
typedef unsigned u32x2 __attribute__((ext_vector_type(2)));
typedef short bf16x8 __attribute__((ext_vector_type(8)));

constexpr int D = 2048, NTOK = 8192, NCTX = 4096, IN_DIM = 17440, IN_PAD = 17664, DFF = 8192;
constexpr int NTHR = 512;
constexpr float EPS = 1e-6f;
constexpr size_t MiB = 1u << 20;
constexpr size_t WS_CTL = 0, CTL_BYTES = 32 * 1024;
constexpr size_t WS_MOD = 1 * MiB;
constexpr size_t WS_W = 2 * MiB, W_LSTRIDE = 153 * MiB;
constexpr size_t W_IN = 0, W_BR = 69 * MiB, W_OUT = 81 * MiB, W_FF1 = 89 * MiB, W_FF2 = 121 * MiB;
constexpr size_t WS_X = 308 * MiB;
constexpr size_t WS_H = 372 * MiB;
constexpr size_t WS_FF = 404 * MiB, WS_FB = 436 * MiB;
constexpr size_t WS_HQ = 468 * MiB, WS_HI = 484 * MiB, WS_HGO = 500 * MiB, WS_CU = 516 * MiB, WS_CV = 532 * MiB;
constexpr size_t WS_GQKV = 548 * MiB;
constexpr size_t WS_GGO = 596 * MiB;
constexpr size_t WS_GATES = 612 * MiB;
constexpr size_t WS_GAB = 708 * MiB;
constexpr size_t WS_GQ = 709 * MiB, WS_GK = 741 * MiB, WS_GV = 773 * MiB;
constexpr size_t WS_OA = 805 * MiB, WS_OB = 821 * MiB, WS_OC = 837 * MiB;
constexpr size_t WS_END = 853 * MiB;
constexpr size_t WS_OSH = WS_H;
constexpr size_t WS_OSG = WS_GQKV;
constexpr size_t WS_FFH = WS_FF;
constexpr size_t WS_MERGED = WS_GV;
constexpr int CW_QUEUE = 64;
constexpr int CW_BAR = 4096;
constexpr int LDS_MISC = 132096, LDS_BYTES = 132096 + 512;
constexpr size_t OUT_Y = 0, OUT_SHG = (size_t)NTOK * D, OUT_SGDN = OUT_SHG + (size_t)16 * 2 * 2 * 8 * 16384;
constexpr int N_PHASES = 22;

__device__ __forceinline__ int otid() { int t = threadIdx.x; asm volatile("" : "+v"(t)); return t; }
__device__ __forceinline__ int obid() { int t = blockIdx.x; asm volatile("" : "+s"(t)); return t; }
struct Args { const float* in[27]; float* out; unsigned char* ws; int ph_lo, ph_hi; };
typedef const Args __attribute__((address_space(4))) KArgs;
__device__ __forceinline__ KArgs* get_args() { KArgs* p = (KArgs*)__builtin_amdgcn_kernarg_segment_ptr(); asm volatile("" : "+s"(p)); return p; }

__device__ __forceinline__ unsigned f2bf(float f) { unsigned u = __builtin_bit_cast(unsigned, f); return (u + 0x7fffu + ((u >> 16) & 1u)) >> 16; }
typedef __bf16 bf16x2_nat __attribute__((ext_vector_type(2)));
__device__ __forceinline__ unsigned pk2(float lo, float hi) { const f32x2 v = {lo, hi}; return __builtin_bit_cast(unsigned, __builtin_convertvector(v, bf16x2_nat)); }
__device__ __forceinline__ float bf_lo(unsigned w) { return __builtin_bit_cast(float, w << 16); }
__device__ __forceinline__ float bf_hi(unsigned w) { return __builtin_bit_cast(float, w & 0xffff0000u); }
__device__ __forceinline__ float wave_sum(float v) {
#pragma unroll
    for (int o = 1; o < 64; o <<= 1) v += __shfl_xor(v, o);
    return v;
}
__device__ __forceinline__ float sigmoidf_(float x) { return __builtin_amdgcn_rcpf(1.0f + __expf(-x)); }
__device__ __forceinline__ float siluf_(float x) { return x * __builtin_amdgcn_rcpf(1.0f + __expf(-x)); }
__device__ __forceinline__ float geluf_(float x) { return 0.5f * x * (1.0f + erff(x * 0.70710678118f)); }
#define LDS_BARRIER() do { asm volatile("s_waitcnt lgkmcnt(0)" ::: "memory"); __builtin_amdgcn_s_barrier(); asm volatile("" ::: "memory"); } while (0)
__device__ __forceinline__ float red16(float x) {
    int t;
    t = __builtin_amdgcn_update_dpp(0, __builtin_bit_cast(int, x), 0xB1, 0xF, 0xF, false); x += __builtin_bit_cast(float, t);
    t = __builtin_amdgcn_update_dpp(0, __builtin_bit_cast(int, x), 0x4E, 0xF, 0xF, false); x += __builtin_bit_cast(float, t);
    t = __builtin_amdgcn_update_dpp(0, __builtin_bit_cast(int, x), 0x141, 0xF, 0xF, false); x += __builtin_bit_cast(float, t);
    t = __builtin_amdgcn_update_dpp(0, __builtin_bit_cast(int, x), 0x140, 0xF, 0xF, false); x += __builtin_bit_cast(float, t);
    return x;
}
struct TItem { const float* p; bf16_t* q; int N, K; };
constexpr int TI_IN = 32 * 545, TI_BR = 16 * 64, TI_OUT = 32 * 64, TI_F1 = 32 * 256, TI_F2 = 128 * 64, TI_L = TI_IN + 3 * TI_BR + TI_OUT + TI_F1 + TI_F2;
__device__ __forceinline__ void titem_decode(KArgs& a, int it, int lane, TItem& t) {
    const int l = it / TI_L; int r = it - l * TI_L;
    unsigned char* wl = a.ws + WS_W + (size_t)l * W_LSTRIDE;
    const float* W; bf16_t* WT; int K, N; bool remap = false;
    if (r < TI_IN) { W = a.in[10] + (size_t)l * 2048 * IN_DIM; K = 2048; N = IN_DIM; WT = (bf16_t*)(wl + W_IN); remap = true; }
    else if ((r -= TI_IN) < TI_BR) { W = a.in[20] + (size_t)l * 1024 * 2048; K = 1024; N = 2048; WT = (bf16_t*)(wl + W_BR); }
    else if ((r -= TI_BR) < TI_BR) { W = a.in[21] + (size_t)l * 1024 * 2048; K = 1024; N = 2048; WT = (bf16_t*)(wl + W_BR + 4 * MiB); }
    else if ((r -= TI_BR) < TI_BR) { W = a.in[22] + (size_t)l * 1024 * 2048; K = 1024; N = 2048; WT = (bf16_t*)(wl + W_BR + 8 * MiB); }
    else if ((r -= TI_BR) < TI_OUT) { W = a.in[23] + (size_t)l * 2048 * 2048; K = 2048; N = 2048; WT = (bf16_t*)(wl + W_OUT); }
    else if ((r -= TI_OUT) < TI_F1) { W = a.in[24] + (size_t)l * 2048 * 8192; K = 2048; N = 8192; WT = (bf16_t*)(wl + W_FF1); }
    else { r -= TI_F1; W = a.in[25] + (size_t)l * 8192 * 2048; K = 8192; N = 2048; WT = (bf16_t*)(wl + W_FF2); }
    const int nblk = N / 32, kb = r / nblk, nb = r - kb * nblk, k0 = 64 * kb, n0 = 32 * nb;
    int drow0 = n0;
    if (remap) drow0 = (n0 < 11264) ? n0 : ((n0 < 11296) ? 17408 : n0 - 32);
    t.p = W + (size_t)(k0 + (lane >> 3)) * N + n0 + 4 * (lane & 7); t.N = N; t.K = K;
    t.q = WT + (size_t)(drow0 + (lane >> 3)) * K + k0 + 8 * (lane & 7);
}
__device__ __forceinline__ void titem_load(const TItem& t, f32x4 (&v)[8]) {
#pragma unroll
    for (int i = 0; i < 8; ++i) v[i] = __builtin_nontemporal_load((const f32x4*)(t.p + (size_t)(8 * i) * t.N));
}
__device__ __forceinline__ void titem_store(const TItem& t, const f32x4 (&v)[8], LAS float* scr, int lane) {
    const int kr = lane >> 3, n4 = 4 * (lane & 7);
#pragma unroll
    for (int i = 0; i < 8; ++i) { LAS float* d = scr + (kr + 8 * i) * 33 + n4; d[0] = v[i].x; d[1] = v[i].y; d[2] = v[i].z; d[3] = v[i].w; }
    asm volatile("s_waitcnt lgkmcnt(0)" ::: "memory");
    const int c = lane & 7;
#pragma unroll
    for (int j = 0; j < 4; ++j) { const int n = (lane >> 3) + 8 * j; const LAS float* s = scr + (8 * c) * 33 + n;
        u32x4 o; o.x = pk2(s[0 * 33], s[1 * 33]); o.y = pk2(s[2 * 33], s[3 * 33]); o.z = pk2(s[4 * 33], s[5 * 33]); o.w = pk2(s[6 * 33], s[7 * 33]);
        *(u32x4*)(t.q + (size_t)(8 * j) * t.K) = o; }
    asm volatile("s_waitcnt lgkmcnt(0)" ::: "memory");
}

__device__ __forceinline__ void titem_range(KArgs& a, LAS float* scr, int lane, int it0, int tot, int step) {
    TItem ta, tb; f32x4 va[8], vb[8];
    int it = it0;
    if (it < tot) { titem_decode(a, it, lane, ta); titem_load(ta, va); }
    for (;;) {
        if (it >= tot) break;
        if (it + step < tot) { titem_decode(a, it + step, lane, tb); titem_load(tb, vb); }
        titem_store(ta, va, scr, lane);
        it += step;
        if (it >= tot) break;
        if (it + step < tot) { titem_decode(a, it + step, lane, ta); titem_load(ta, va); }
        titem_store(tb, vb, scr, lane);
        it += step;
    }
}
constexpr int BG_PER = 64;
constexpr int BG0_FIRST = TI_IN, BG0_END = TI_L + TI_IN, BG0_SUPER = (BG0_END - BG0_FIRST + BG_PER - 1) / BG_PER;
constexpr int BG1_FIRST = TI_L + TI_IN, BG1_END = 2 * TI_L, BG1_SUPER = (BG1_END - BG1_FIRST + BG_PER - 1) / BG_PER;
__device__ __forceinline__ void conv_super_item(KArgs& a, LAS unsigned char* lds, int first, int last, int sidx) {
    const int tid = otid(), lane = tid & 63, wave = tid >> 6;
    const int base = first + BG_PER * sidx, end = (base + BG_PER < last) ? base + BG_PER : last;
    titem_range(a, (LAS float*)(lds + wave * 16384), lane, base + wave, end, 8);
    __syncthreads();
}

__device__ __forceinline__ void phase_prologue(KArgs& a, LAS unsigned char* lds) {
    const int tid = otid(), lane = tid & 63, wave = tid >> 6, G = gridDim.x;
    float* MOD = (float*)(a.ws + WS_MOD);
    LAS float* sc = (LAS float*)lds;
    LAS float* red = (LAS float*)(lds + 40960);
    for (int i = tid; i < 5 * 2048; i += NTHR) { const int v = i >> 11, k = i & 2047; const float x = (v == 0) ? a.in[5][k] : a.in[2][(v - 1) * 2048 + k]; sc[i] = siluf_(x); }
    __syncthreads();
    for (int chunk = blockIdx.x; chunk < 256; chunk += G) {
        const int l = chunk >> 7, n0 = (chunk & 127) * 96;
        if (tid < 384) {
            const int kg = tid / 24, ln = tid % 24;
            const float* W = a.in[8] + ((size_t)l * 2048 + kg * 128) * 12288 + n0 + 4 * ln;
            f32x4 acc[5];
#pragma unroll
            for (int v = 0; v < 5; ++v) acc[v] = (f32x4){0.f, 0.f, 0.f, 0.f};
#pragma unroll 16
            for (int k = 0; k < 128; ++k) {
                const f32x4 w = __builtin_nontemporal_load((const f32x4*)(W + (size_t)k * 12288));
#pragma unroll
                for (int v = 0; v < 5; ++v) { const float s = sc[v * 2048 + kg * 128 + k]; acc[v] += s * w; }
            }
#pragma unroll
            for (int v = 0; v < 5; ++v) *(LAS f32x4*)(red + (kg * 5 + v) * 96 + 4 * ln) = acc[v];
        }
        __syncthreads();
        if (tid < 480) { const int v = tid / 96, c = tid % 96; float s = 0.f;
#pragma unroll
            for (int kg = 0; kg < 16; ++kg) s += red[(kg * 5 + v) * 96 + c];
            MOD[(l * 5 + v) * 12288 + n0 + c] = s + a.in[9][l * 12288 + n0 + c]; }
        __syncthreads();
    }
    LAS float* scr = (LAS float*)(lds + wave * 16384);
    const int gw = blockIdx.x * 8 + wave, NGW = G * 8;
    titem_range(a, scr, lane, gw, TI_IN, NGW);
    for (int i = blockIdx.x * NTHR + tid; i < 2 * 57344; i += G * NTHR) { const int l = i / 57344, j = i - l * 57344;
        *(u32x4*)(a.ws + WS_W + (size_t)l * W_LSTRIDE + W_IN + (size_t)IN_DIM * 4096 + (size_t)j * 16) = (u32x4){0u, 0u, 0u, 0u}; }
}

__device__ __forceinline__ int mod_vec_of_row(int r) { return r < NCTX ? 0 : 1 + ((r - NCTX) >> 10); }

__device__ __forceinline__ void load_row8(const float* srcf, const bf16_t* srcb, int lane, float (&v)[4][8]) {
#pragma unroll
    for (int j = 0; j < 4; ++j) { const int c = 8 * (64 * j + lane);
        if (srcf) { const f32x4 x0 = *(const f32x4*)(srcf + c), x1 = *(const f32x4*)(srcf + c + 4);
            v[j][0] = x0.x; v[j][1] = x0.y; v[j][2] = x0.z; v[j][3] = x0.w; v[j][4] = x1.x; v[j][5] = x1.y; v[j][6] = x1.z; v[j][7] = x1.w; }
        else { const u32x4 p = *(const u32x4*)(srcb + c);
            v[j][0] = bf_lo(p.x); v[j][1] = bf_hi(p.x); v[j][2] = bf_lo(p.y); v[j][3] = bf_hi(p.y); v[j][4] = bf_lo(p.z); v[j][5] = bf_hi(p.z); v[j][6] = bf_lo(p.w); v[j][7] = bf_hi(p.w); } }
}
__device__ __forceinline__ void phase_norm_mod(KArgs& a, int l, int which) {
    const int tid = otid(), lane = tid & 63, wave = tid >> 6, gw = blockIdx.x * 8 + wave, NGW = gridDim.x * 8;
    bf16_t* X = (bf16_t*)(a.ws + WS_X); bf16_t* H = (bf16_t*)(a.ws + WS_H); const float* MOD = (const float*)(a.ws + WS_MOD);
    const bool first = (which == 0 && l == 0);
    const float* gvec = (which ? a.in[7] : a.in[6]) + l * 2048;
    for (int r0 = gw; r0 < NTOK; r0 += 2 * NGW) {
        float v[2][4][8];
#pragma unroll
        for (int u = 0; u < 2; ++u) { const int r = r0 + u * NGW;
            if (r < NTOK) load_row8(first ? (r < NCTX ? a.in[0] + (size_t)r * D : a.in[1] + (size_t)(r - NCTX) * D) : nullptr, X + (size_t)r * D, lane, v[u]); }
#pragma unroll
        for (int u = 0; u < 2; ++u) { const int r = r0 + u * NGW;
            if (r < NTOK) { float ss = 0.f;
#pragma unroll
                for (int j = 0; j < 4; ++j)
#pragma unroll
                    for (int e = 0; e < 8; ++e) ss += v[u][j][e] * v[u][j][e];
                const float rstd = rsqrtf(wave_sum(ss) * (1.0f / D) + EPS);
                const float* mod = MOD + (size_t)(l * 5 + mod_vec_of_row(r)) * 12288 + (which ? 6144 : 0);
#pragma unroll
                for (int j = 0; j < 4; ++j) { const int c = 8 * (64 * j + lane); float y[8];
#pragma unroll
                    for (int hf = 0; hf < 2; ++hf) { const f32x4 gv = *(const f32x4*)(gvec + c + 4 * hf), sh = *(const f32x4*)(mod + c + 4 * hf), scl = *(const f32x4*)(mod + 2048 + c + 4 * hf);
                        y[4 * hf] = v[u][j][4 * hf] * rstd * gv.x * (1.0f + scl.x) + sh.x; y[4 * hf + 1] = v[u][j][4 * hf + 1] * rstd * gv.y * (1.0f + scl.y) + sh.y;
                        y[4 * hf + 2] = v[u][j][4 * hf + 2] * rstd * gv.z * (1.0f + scl.z) + sh.z; y[4 * hf + 3] = v[u][j][4 * hf + 3] * rstd * gv.w * (1.0f + scl.w) + sh.w; }
                    u32x4 o; o.x = pk2(y[0], y[1]); o.y = pk2(y[2], y[3]); o.z = pk2(y[4], y[5]); o.w = pk2(y[6], y[7]);
                    *(u32x4*)(H + (size_t)r * D + c) = o;
                    if (first) { u32x4 xo; xo.x = pk2(v[u][j][0], v[u][j][1]); xo.y = pk2(v[u][j][2], v[u][j][3]); xo.z = pk2(v[u][j][4], v[u][j][5]); xo.w = pk2(v[u][j][6], v[u][j][7]); *(u32x4*)(X + (size_t)r * D + c) = xo; } } } }
    }
}
__device__ __forceinline__ void phase_final_norm(KArgs& a) {
    const int tid = otid(), lane = tid & 63, wave = tid >> 6, gw = blockIdx.x * 8 + wave, NGW = gridDim.x * 8;
    const bf16_t* X = (const bf16_t*)(a.ws + WS_X);
    for (int r = gw; r < NTOK; r += NGW) {
        float v[4][8]; load_row8(nullptr, X + (size_t)r * D, lane, v);
        float ss = 0.f;
#pragma unroll
        for (int j = 0; j < 4; ++j)
#pragma unroll
            for (int e = 0; e < 8; ++e) ss += v[j][e] * v[j][e];
        const float rstd = rsqrtf(wave_sum(ss) * (1.0f / D) + EPS);
#pragma unroll
        for (int j = 0; j < 4; ++j) { const int c = 8 * (64 * j + lane);
            const f32x4 g0 = *(const f32x4*)(a.in[26] + c), g1 = *(const f32x4*)(a.in[26] + c + 4);
            float* o = a.out + OUT_Y + (size_t)r * D + c;
            *(f32x4*)o = (f32x4){v[j][0] * rstd * g0.x, v[j][1] * rstd * g0.y, v[j][2] * rstd * g0.z, v[j][3] * rstd * g0.w};
            *(f32x4*)(o + 4) = (f32x4){v[j][4] * rstd * g1.x, v[j][5] * rstd * g1.y, v[j][6] * rstd * g1.z, v[j][7] * rstd * g1.w}; }
    }
}

enum { M_ID = 0, M_SILU = 1, M_GELU = 2, M_SIG = 3, M_FG = 4 };
__device__ __forceinline__ float gelu_as(float v) {
    const float av = fabsf(v), t = __builtin_amdgcn_rcpf(fmaf(av, 0.2316418882f, 1.0f));
    float q = fmaf(t, 0.5307027145f, -0.7265760135f); q = fmaf(q, t, 0.7107068705f); q = fmaf(q, t, -0.142248368f); q = fmaf(q, t, 0.127414796f); q = q * t;
    const float e = __builtin_amdgcn_exp2f(v * v * (-0.72134752044f));
    const float mm = v * (q * e);
    return v < 0.f ? mm : v - mm;
}
__device__ __forceinline__ f32x4 act4(f32x4 x, int mode, f32x4 lb) {
    f32x4 r = x;
    if (mode == M_SILU) { r.x = siluf_(x.x); r.y = siluf_(x.y); r.z = siluf_(x.z); r.w = siluf_(x.w); }
    else if (mode == M_GELU) { r.x = gelu_as(x.x); r.y = gelu_as(x.y); r.z = gelu_as(x.z); r.w = gelu_as(x.w); }
    else if (mode == M_SIG) { r.x = sigmoidf_(x.x); r.y = sigmoidf_(x.y); r.z = sigmoidf_(x.z); r.w = sigmoidf_(x.w); }
    else if (mode == M_FG) { r.x = sigmoidf_(x.x); r.y = sigmoidf_(x.y); r.z = sigmoidf_(x.z); r.w = sigmoidf_(x.w); r = lb + (1.0f - lb) * r; }
    return r;
}
struct EpiIn {
    static constexpr bool PERM = true, AFTER_DRAIN = false, KEEP = false;
    unsigned char* ws; const float* hg_lb; const float* A_log; const float* dt_bias; int layer;
    __device__ __forceinline__ void operator()(const f32x4 (&acc)[2][2][4][2], const pg8::Unit& u, int wr, int wc, int fr, int fq) const {
        const int pn = u.pn;
        const float* hg_lb = this->hg_lb; const float* A_log = this->A_log; const float* dt_bias = this->dt_bias; unsigned char* ws = this->ws;
        asm volatile("" : "+s"(hg_lb), "+s"(A_log), "+s"(dt_bias), "+s"(ws));
        if (pn == 68) {
            if (wc != 0) return;
            float* GAB = (float*)(ws + WS_GAB);
#pragma unroll
            for (int n = 0; n < 2; ++n) {
                f32x4 al = (f32x4){0.f, 0.f, 0.f, 0.f}, db = al;
                if (fq < 2) { const f32x4 A = *(const f32x4*)(A_log + (layer * 2 + fq) * 8 + 4 * n); db = *(const f32x4*)(dt_bias + (layer * 2 + fq) * 8 + 4 * n);
                    al.x = -__expf(A.x); al.y = -__expf(A.y); al.z = -__expf(A.z); al.w = -__expf(A.w); }
#pragma unroll
                for (int ai = 0; ai < 2; ++ai)
#pragma unroll
                    for (int m = 0; m < 4; ++m) { const int row = u.pm * 256 + ai * 128 + wr * 64 + m * 16 + fr;
                        const f32x4 x = acc[ai][0][m][n]; f32x4 y;
                        if (fq < 2) { const f32x4 z = x + db;
                            y.x = al.x * ((z.x > 20.f) ? z.x : log1pf(__expf(z.x))); y.y = al.y * ((z.y > 20.f) ? z.y : log1pf(__expf(z.y)));
                            y.z = al.z * ((z.z > 20.f) ? z.z : log1pf(__expf(z.z))); y.w = al.w * ((z.w > 20.f) ? z.w : log1pf(__expf(z.w))); }
                        else { y.x = sigmoidf_(x.x); y.y = sigmoidf_(x.y); y.z = sigmoidf_(x.z); y.w = sigmoidf_(x.w); }
                        *(f32x4*)(GAB + (size_t)row * 32 + 8 * fq + 4 * n) = y;
                        asm volatile("" ::: "memory"); }
            }
            return;
        }
        int mode, ld, cb; size_t off; bool f32o = false; int dir = 0;
        if (pn < 4) { mode = M_SILU; off = WS_HQ; ld = 1024; cb = pn * 256; }
        else if (pn < 8) { mode = M_ID; off = WS_HI; ld = 1024; cb = (pn - 4) * 256; }
        else if (pn < 12) { mode = M_SILU; off = WS_HGO; ld = 1024; cb = (pn - 8) * 256; }
        else if (pn < 16) { mode = M_FG; off = WS_FF; ld = 1024; cb = (pn - 12) * 256; f32o = true; dir = 0; }
        else if (pn < 20) { mode = M_FG; off = WS_FB; ld = 1024; cb = (pn - 16) * 256; f32o = true; dir = 1; }
        else if (pn < 24) { mode = M_GELU; off = WS_CU; ld = 1024; cb = (pn - 20) * 256; }
        else if (pn < 28) { mode = M_GELU; off = WS_CV; ld = 1024; cb = (pn - 24) * 256; }
        else if (pn < 40) { mode = M_ID; off = WS_GQKV; ld = 3072; cb = (pn - 28) * 256; }
        else if (pn < 44) { mode = M_SILU; off = WS_GGO; ld = 1024; cb = (pn - 40) * 256; }
        else { mode = M_SIG; off = WS_GATES; ld = 6144; cb = (pn - 44) * 256; }
        unsigned char* base = ws + off;
#pragma unroll
        for (int bj = 0; bj < 2; ++bj) {
            const int col = cb + bj * 128 + wc * 32 + 8 * fq;
            f32x4 lb0 = (f32x4){0.f, 0.f, 0.f, 0.f}, lb1 = lb0;
            if (mode == M_FG && layer == 1) {
                const f32x4 a0 = *(const f32x4*)(hg_lb + dir * 1024 + col), a1 = *(const f32x4*)(hg_lb + dir * 1024 + col + 4);
                const f32x4 b0 = *(const f32x4*)(hg_lb + (2 + dir) * 1024 + col), b1 = *(const f32x4*)(hg_lb + (2 + dir) * 1024 + col + 4);
                lb0.x = sigmoidf_(b0.x - a0.x); lb0.y = sigmoidf_(b0.y - a0.y); lb0.z = sigmoidf_(b0.z - a0.z); lb0.w = sigmoidf_(b0.w - a0.w);
                lb1.x = sigmoidf_(b1.x - a1.x); lb1.y = sigmoidf_(b1.y - a1.y); lb1.z = sigmoidf_(b1.z - a1.z); lb1.w = sigmoidf_(b1.w - a1.w);
            }
#pragma unroll
            for (int ai = 0; ai < 2; ++ai)
#pragma unroll
                for (int m = 0; m < 4; ++m) { const int row = u.pm * 256 + ai * 128 + wr * 64 + m * 16 + fr;
                    const f32x4 y0 = act4(acc[ai][bj][m][0], mode, lb0), y1 = act4(acc[ai][bj][m][1], mode, lb1);
                    if (f32o) { float* dst = (float*)base + (size_t)row * ld + col; *(f32x4*)dst = y0; *(f32x4*)(dst + 4) = y1; }
                    else { bf16_t* dst = (bf16_t*)base + (size_t)row * ld + col;
                        u32x4 w; w.x = pk2(y0.x, y0.y); w.y = pk2(y0.z, y0.w); w.z = pk2(y1.x, y1.y); w.w = pk2(y1.z, y1.w); *(u32x4*)dst = w; }
                    asm volatile("" ::: "memory");
                }
        }
    }
};
struct Br3Order {
    pg8::StaticOrder base;
    __device__ __forceinline__ bool next(int i, pg8::Unit& u) const { const int rd = i / 3, br = i - 3 * rd; pg8::Unit ub; if (!base.next(rd, ub)) return false; u.pm = br * 32 + ub.pm; u.pn = br * 8 + ub.pn; return true; }
    __device__ __forceinline__ void a_ready(const pg8::Unit&) const {}
    __device__ __forceinline__ void done(const pg8::Unit&) const {}
};
struct EpiBr3 {
    static constexpr bool PERM = true, AFTER_DRAIN = false, KEEP = true;
    unsigned char* ws;
    __device__ __forceinline__ bool keep(const pg8::Unit& u) const { return u.pm < 64; }
    __device__ __forceinline__ void operator()(f32x4 (&acc)[2][2][4][2], const pg8::Unit& u, int wr, int wc, int fr, int fq) const {
        const bf16_t* GATES = (const bf16_t*)(ws + WS_GATES); bf16_t* MG = (bf16_t*)(ws + WS_MERGED);
        const int br = u.pm >> 5, pm = u.pm & 31, pn = u.pn & 7;
#pragma unroll
        for (int ai = 0; ai < 2; ++ai)
#pragma unroll
            for (int m = 0; m < 4; ++m) { const int row = pm * 256 + ai * 128 + wr * 64 + m * 16 + fr;
#pragma unroll
                for (int bj = 0; bj < 2; ++bj) { const int col = pn * 256 + bj * 128 + wc * 32 + 8 * fq;
                    const bf16_t* gp = GATES + (size_t)row * 6144 + col;
                    const u32x4 gw = *(const u32x4*)(gp + br * 2048);
                    f32x4 c0 = (f32x4){bf_lo(gw.x), bf_hi(gw.x), bf_lo(gw.y), bf_hi(gw.y)}, c1 = (f32x4){bf_lo(gw.z), bf_hi(gw.z), bf_lo(gw.w), bf_hi(gw.w)};
                    if (br > 0) { c0 = __builtin_elementwise_max(c0, (f32x4){1e-6f, 1e-6f, 1e-6f, 1e-6f}); c1 = __builtin_elementwise_max(c1, (f32x4){1e-6f, 1e-6f, 1e-6f, 1e-6f}); }
                    if (br < 2) { const u32x4 gn = *(const u32x4*)(gp + (br + 1) * 2048);
                        f32x4 n0 = (f32x4){bf_lo(gn.x), bf_hi(gn.x), bf_lo(gn.y), bf_hi(gn.y)}, n1 = (f32x4){bf_lo(gn.z), bf_hi(gn.z), bf_lo(gn.w), bf_hi(gn.w)};
                        n0 = __builtin_elementwise_max(n0, (f32x4){1e-6f, 1e-6f, 1e-6f, 1e-6f}); n1 = __builtin_elementwise_max(n1, (f32x4){1e-6f, 1e-6f, 1e-6f, 1e-6f});
                        c0.x *= __builtin_amdgcn_rcpf(n0.x); c0.y *= __builtin_amdgcn_rcpf(n0.y); c0.z *= __builtin_amdgcn_rcpf(n0.z); c0.w *= __builtin_amdgcn_rcpf(n0.w);
                        c1.x *= __builtin_amdgcn_rcpf(n1.x); c1.y *= __builtin_amdgcn_rcpf(n1.y); c1.z *= __builtin_amdgcn_rcpf(n1.z); c1.w *= __builtin_amdgcn_rcpf(n1.w);
                        acc[ai][bj][m][0] *= c0; acc[ai][bj][m][1] *= c1; }
                    else { const f32x4 v0 = acc[ai][bj][m][0] * c0, v1 = acc[ai][bj][m][1] * c1;
                        u32x4 w; w.x = pk2(v0[0], v0[1]); w.y = pk2(v0[2], v0[3]); w.z = pk2(v1[0], v1[1]); w.w = pk2(v1[2], v1[3]); *(u32x4*)(MG + (size_t)row * D + col) = w; }
                } }
    }
};
struct EpiRes {
    static constexpr bool PERM = true, AFTER_DRAIN = false, KEEP = false;
    unsigned char* ws; int layer, goff;
    __device__ __forceinline__ void operator()(const f32x4 (&acc)[2][2][4][2], const pg8::Unit& u, int wr, int wc, int fr, int fq) const {
        bf16_t* X = (bf16_t*)(ws + WS_X); const float* MOD = (const float*)(ws + WS_MOD);
#pragma unroll
        for (int ai = 0; ai < 2; ++ai)
#pragma unroll
            for (int m = 0; m < 4; ++m) { const int row = u.pm * 256 + ai * 128 + wr * 64 + m * 16 + fr;
                const float* gate = MOD + (size_t)(layer * 5 + mod_vec_of_row(row)) * 12288 + goff;
#pragma unroll
                for (int bj = 0; bj < 2; ++bj) { const int col = u.pn * 256 + bj * 128 + wc * 32 + 8 * fq;
                    bf16_t* x = X + (size_t)row * D + col;
                    const f32x4 g0 = *(const f32x4*)(gate + col), g1 = *(const f32x4*)(gate + col + 4);
                    const u32x4 p = *(const u32x4*)x;
                    const f32x4 y0 = (f32x4){bf_lo(p.x), bf_hi(p.x), bf_lo(p.y), bf_hi(p.y)} + g0 * acc[ai][bj][m][0], y1 = (f32x4){bf_lo(p.z), bf_hi(p.z), bf_lo(p.w), bf_hi(p.w)} + g1 * acc[ai][bj][m][1];
                    u32x4 w; w.x = pk2(y0.x, y0.y); w.y = pk2(y0.z, y0.w); w.z = pk2(y1.x, y1.y); w.w = pk2(y1.z, y1.w); *(u32x4*)x = w; } }
    }
};
struct EpiRelu2 {
    static constexpr bool PERM = true, AFTER_DRAIN = false, KEEP = false;
    unsigned char* ws;
    __device__ __forceinline__ void operator()(const f32x4 (&acc)[2][2][4][2], const pg8::Unit& u, int wr, int wc, int fr, int fq) const {
        bf16_t* FH = (bf16_t*)(ws + WS_FFH);
#pragma unroll
        for (int ai = 0; ai < 2; ++ai)
#pragma unroll
            for (int m = 0; m < 4; ++m) { const int row = u.pm * 256 + ai * 128 + wr * 64 + m * 16 + fr;
#pragma unroll
                for (int bj = 0; bj < 2; ++bj) { const int col = u.pn * 256 + bj * 128 + wc * 32 + 8 * fq;
                    f32x4 v0 = acc[ai][bj][m][0], v1 = acc[ai][bj][m][1];
                    v0 = __builtin_elementwise_max(v0, (f32x4){0.f, 0.f, 0.f, 0.f}); v1 = __builtin_elementwise_max(v1, (f32x4){0.f, 0.f, 0.f, 0.f}); v0 *= v0; v1 *= v1;
                    u32x4 w; w.x = pk2(v0[0], v0[1]); w.y = pk2(v0[2], v0[3]); w.z = pk2(v1[0], v1[1]); w.w = pk2(v1[2], v1[3]);
                    *(u32x4*)(FH + (size_t)row * DFF + col) = w; } }
    }
};

__device__ __forceinline__ void phase_gdn_prep(KArgs& a, int l) {
    const int tid = otid(), lane = tid & 63, wave = tid >> 6, gw = blockIdx.x * 8 + wave, NGW = gridDim.x * 8;
    const int sub = lane >> 4, l16 = lane & 15;
    const bf16_t* RAW = (const bf16_t*)(a.ws + WS_GQKV);
    const float* CW = a.in[16] + (size_t)l * 9 * 3072;
    for (int it = gw * 4 + sub; it < NTOK * 24; it += NGW * 4) {
        const int r = it / 24, ch = it - r * 24, c = ch * 128 + 8 * l16;
        const bool ctx = r < NCTX;
        const int t = ctx ? (r & 255) : ((r - NCTX) & 1023), gr = t >> 6, gc = t & 63;
        float y[8];
#pragma unroll
        for (int e = 0; e < 8; ++e) y[e] = 0.f;
#pragma unroll
        for (int i = 0; i < 3; ++i)
#pragma unroll
            for (int j = 0; j < 3; ++j) {
                bool valid; int dr;
                if (ctx) { const int tt = t + j - 1; valid = (i == 1) && tt >= 0 && tt < 256; dr = j - 1; }
                else { const int rr = gr + i - 1, cc = gc + j - 1; valid = rr >= 0 && rr < 16 && cc >= 0 && cc < 64; dr = (i - 1) * 64 + (j - 1); }
                if (valid) { const u32x4 w = *(const u32x4*)(RAW + (size_t)(r + dr) * 3072 + c);
                    const f32x4 c0 = *(const f32x4*)(CW + (i * 3 + j) * 3072 + c), c1 = *(const f32x4*)(CW + (i * 3 + j) * 3072 + c + 4);
                    y[0] += c0.x * bf_lo(w.x); y[1] += c0.y * bf_hi(w.x); y[2] += c0.z * bf_lo(w.y); y[3] += c0.w * bf_hi(w.y);
                    y[4] += c1.x * bf_lo(w.z); y[5] += c1.y * bf_hi(w.z); y[6] += c1.z * bf_lo(w.w); y[7] += c1.w * bf_hi(w.w); }
            }
        float ss = 0.f;
#pragma unroll
        for (int e = 0; e < 8; ++e) { y[e] = siluf_(y[e]); ss += y[e] * y[e]; }
        ss = red16(ss);
        float sc = 1.0f;
        if (ch < 16) sc = rsqrtf(ss + EPS) * (ch < 8 ? 0.08838834764831845f : 1.0f);
        bf16_t* dst = (bf16_t*)(a.ws + (ch < 8 ? WS_GQ : (ch < 16 ? WS_GK : WS_GV))) + (size_t)r * 1024 + (ch & 7) * 128 + 8 * l16;
        { u32x4 o; o.x = pk2(y[0] * sc, y[1] * sc); o.y = pk2(y[2] * sc, y[3] * sc); o.z = pk2(y[4] * sc, y[5] * sc); o.w = pk2(y[6] * sc, y[7] * sc); *(u32x4*)dst = o; }
    }
}

constexpr int HC_QT = 0, HC_KT = 4352, HC_KD = 8704, HC_VT = 18944, HC_G = 29184, HC_BUF = 29696, HC_TOT = 2 * HC_BUF;
__device__ __forceinline__ void hgrn_chunk_item(KArgs& a, LAS unsigned char* lds, int l, int s, int h, int dir) {
    const int tid = otid(), lane = tid & 63, w = tid >> 6, fr = lane & 15, fq = lane >> 4;
    const int d = tid & 127, part = tid >> 7;
    const int L = (s < 16) ? 256 : 1024, row0 = (s < 16) ? s * 256 : NCTX + (s - 16) * 1024, nchunk = L / 16;
    f32x4 acc[8];
    if (s >= 16) { const float* st = a.in[3] + ((((size_t)(s - 16) * 2 + l) * 2 + dir) * 8 + h) * 16384;
#pragma unroll
        for (int dt = 0; dt < 8; ++dt)
#pragma unroll
            for (int jj = 0; jj < 4; ++jj) acc[dt][jj] = st[(16 * dt + 4 * fq + jj) * 128 + 16 * w + fr]; }
    else {
#pragma unroll
        for (int dt = 0; dt < 8; ++dt) acc[dt] = (f32x4){0.f, 0.f, 0.f, 0.f}; }
    const float* F = (const float*)(a.ws + (dir ? WS_FB : WS_FF));
    const bf16_t* HQ = (const bf16_t*)(a.ws + WS_HQ); const bf16_t* HI = (const bf16_t*)(a.ws + WS_HI);
    bf16_t* OS = (bf16_t*)(a.ws + WS_OSH) + (size_t)dir * NTOK * 1024;
    LAS float* TOT = (LAS float*)(lds + HC_TOT);
    float pf[4]; unsigned pq[4], pv[4];
#define HC_ROW(c, j) (row0 + (dir ? L - 1 - (16 * (c) + (j)) : 16 * (c) + (j)))
#define HC_PREFETCH(c) do { _Pragma("unroll") for (int i = 0; i < 4; ++i) { const size_t o_ = (size_t)HC_ROW(c, 4 * part + i) * 1024 + h * 128 + d; pf[i] = F[o_]; pq[i] = HQ[o_]; pv[i] = HI[o_]; } } while (0)
    HC_PREFETCH(0);
    float cs[4], omf[4], qf[4];
    { LAS unsigned char* B = lds;
        { float run = 0.f;
#pragma unroll
          for (int i = 0; i < 4; ++i) { run += __logf(fmaxf(pf[i], 1e-30f)); cs[i] = run; omf[i] = 1.0f - pf[i]; qf[i] = __builtin_bit_cast(float, pq[i] << 16); } }
        TOT[part * 128 + d] = cs[3];
        { u32x2 t; t.x = pv[0] | (pv[1] << 16); t.y = pv[2] | (pv[3] << 16); *(LAS u32x2*)(B + HC_VT + d * 80 + 8 * part) = t; }
        if (1 < nchunk) HC_PREFETCH(1);
        LDS_BARRIER();
        { const float t0 = TOT[d], t1 = TOT[128 + d], t2 = TOT[256 + d], t3 = TOT[384 + d];
          const float pre = (part > 0 ? t0 : 0.f) + (part > 1 ? t1 : 0.f) + (part > 2 ? t2 : 0.f), blast = (t0 + t1) + (t2 + t3);
          float kd[4];
#pragma unroll
          for (int i = 0; i < 4; ++i) { const float b = pre + cs[i];
              const unsigned qk = pk2(qf[i] * __expf(b), omf[i] * __expf(fminf(-b, 80.0f)));
              ((LAS bf16_t*)(B + HC_QT))[(4 * part + i) * 136 + d] = (bf16_t)(qk & 0xffffu);
              ((LAS bf16_t*)(B + HC_KT))[(4 * part + i) * 136 + d] = (bf16_t)(qk >> 16);
              kd[i] = omf[i] * __expf(blast - b); }
          { u32x2 t; t.x = pk2(kd[0], kd[1]); t.y = pk2(kd[2], kd[3]); *(LAS u32x2*)(B + HC_KD + d * 80 + 8 * part) = t; }
          if (part == 0) ((LAS float*)(B + HC_G))[d] = __expf(blast); }
        LDS_BARRIER(); }
    for (int c = 0; c < nchunk; ++c) {
        const bool hn = c + 1 < nchunk;
        if (hn) { LAS unsigned char* B = lds + ((c + 1) & 1) * HC_BUF;
        { float run = 0.f;
#pragma unroll
          for (int i = 0; i < 4; ++i) { run += __logf(fmaxf(pf[i], 1e-30f)); cs[i] = run; omf[i] = 1.0f - pf[i]; qf[i] = __builtin_bit_cast(float, pq[i] << 16); } }
        TOT[part * 128 + d] = cs[3];
        { u32x2 t; t.x = pv[0] | (pv[1] << 16); t.y = pv[2] | (pv[3] << 16); *(LAS u32x2*)(B + HC_VT + d * 80 + 8 * part) = t; }
            if (c + 2 < nchunk) HC_PREFETCH(c + 2); }
        LDS_BARRIER();
        if (hn) { LAS unsigned char* B = lds + ((c + 1) & 1) * HC_BUF;
        { const float t0 = TOT[d], t1 = TOT[128 + d], t2 = TOT[256 + d], t3 = TOT[384 + d];
          const float pre = (part > 0 ? t0 : 0.f) + (part > 1 ? t1 : 0.f) + (part > 2 ? t2 : 0.f), blast = (t0 + t1) + (t2 + t3);
          float kd[4];
#pragma unroll
          for (int i = 0; i < 4; ++i) { const float b = pre + cs[i];
              const unsigned qk = pk2(qf[i] * __expf(b), omf[i] * __expf(fminf(-b, 80.0f)));
              ((LAS bf16_t*)(B + HC_QT))[(4 * part + i) * 136 + d] = (bf16_t)(qk & 0xffffu);
              ((LAS bf16_t*)(B + HC_KT))[(4 * part + i) * 136 + d] = (bf16_t)(qk >> 16);
              kd[i] = omf[i] * __expf(blast - b); }
          { u32x2 t; t.x = pk2(kd[0], kd[1]); t.y = pk2(kd[2], kd[3]); *(LAS u32x2*)(B + HC_KD + d * 80 + 8 * part) = t; }
          if (part == 0) ((LAS float*)(B + HC_G))[d] = __expf(blast); }
        }
        { LAS unsigned char* B = lds + (c & 1) * HC_BUF;
        f32x4 A = (f32x4){0.f, 0.f, 0.f, 0.f};
#pragma unroll
        for (int ks = 0; ks < 4; ++ks) { const bf16x8 kf = *(const LAS bf16x8*)(B + HC_KT + fr * 272 + 64 * ks + 16 * fq), qfr = *(const LAS bf16x8*)(B + HC_QT + fr * 272 + 64 * ks + 16 * fq);
            A = __builtin_amdgcn_mfma_f32_16x16x32_bf16(kf, qfr, A, 0, 0, 0); }
#pragma unroll
        for (int jj = 0; jj < 4; ++jj) if (4 * fq + jj > fr) A[jj] = 0.f;
        u32x4 af; af.x = pk2(A[0], A[1]); af.y = pk2(A[2], A[3]); af.z = 0u; af.w = 0u;
        u32x4 vf; { const u32x2 t = *(const LAS u32x2*)(B + HC_VT + (16 * w + fr) * 80 + 8 * fq); vf.x = t.x; vf.y = t.y; vf.z = 0u; vf.w = 0u; }
        f32x4 o = __builtin_amdgcn_mfma_f32_16x16x32_bf16(__builtin_bit_cast(bf16x8, af), __builtin_bit_cast(bf16x8, vf), (f32x4){0.f, 0.f, 0.f, 0.f}, 0, 0, 0);
#pragma unroll
        for (int ks = 0; ks < 4; ++ks) {
            const u32x2 qa = *(const LAS u32x2*)(B + HC_QT + fr * 272 + 64 * ks + 8 * fq), qb = *(const LAS u32x2*)(B + HC_QT + fr * 272 + 64 * ks + 32 + 8 * fq);
            u32x4 q2; q2.x = qa.x; q2.y = qa.y; q2.z = qb.x; q2.w = qb.y;
            u32x4 sf; sf.x = pk2(acc[2 * ks][0], acc[2 * ks][1]); sf.y = pk2(acc[2 * ks][2], acc[2 * ks][3]); sf.z = pk2(acc[2 * ks + 1][0], acc[2 * ks + 1][1]); sf.w = pk2(acc[2 * ks + 1][2], acc[2 * ks + 1][3]);
            o = __builtin_amdgcn_mfma_f32_16x16x32_bf16(__builtin_bit_cast(bf16x8, q2), __builtin_bit_cast(bf16x8, sf), o, 0, 0, 0); }
#pragma unroll
        for (int jj = 0; jj < 4; jj += 2) { const unsigned op = pk2(o[jj], o[jj + 1]);
            OS[(size_t)HC_ROW(c, 4 * fq + jj) * 1024 + h * 128 + 16 * w + fr] = (bf16_t)(op & 0xffffu); OS[(size_t)HC_ROW(c, 4 * fq + jj + 1) * 1024 + h * 128 + 16 * w + fr] = (bf16_t)(op >> 16); }
#pragma unroll
        for (int dt = 0; dt < 8; ++dt) { const f32x4 g4 = *(const LAS f32x4*)(B + HC_G + (16 * dt + 4 * fq) * 4);
            u32x4 kf; { const u32x2 t = *(const LAS u32x2*)(B + HC_KD + (16 * dt + fr) * 80 + 8 * fq); kf.x = t.x; kf.y = t.y; kf.z = 0u; kf.w = 0u; }
            acc[dt] = __builtin_amdgcn_mfma_f32_16x16x32_bf16(__builtin_bit_cast(bf16x8, kf), __builtin_bit_cast(bf16x8, vf), acc[dt] * g4, 0, 0, 0); }
        }
        LDS_BARRIER();
    }
#undef HC_ROW
#undef HC_PREFETCH
    if (s < 16) { float* so = a.out + OUT_SHG + ((((size_t)s * 2 + l) * 2 + dir) * 8 + h) * 16384;
#pragma unroll
        for (int dt = 0; dt < 8; ++dt)
#pragma unroll
            for (int jj = 0; jj < 4; ++jj) so[(16 * dt + 4 * fq + jj) * 128 + 16 * w + fr] = acc[dt][jj]; }
    __syncthreads();
}


constexpr int GC_KT = 0, GC_QT = 4352, GC_V = 8704, GC_KD = 16896, GC_GS = 27136, GC_BS = 27200, GC_GC = 27264, GC_EG = 27328, GC_AQ = 27392, GC_TT = 27904, GC_BUF = 28416, GC_PRIV = 2 * GC_BUF;
static_assert(GC_PRIV + 1024 <= LDS_MISC, "GDN chunk LDS map");
__device__ __forceinline__ void gdn_chunk_item(KArgs& a, LAS unsigned char* lds, int l, int s, int h, int dir) {
    const int tid = otid(), lane = tid & 63, w = tid >> 6, fr = lane & 15, fq = lane >> 4;
    const int d = tid & 127, part = tid >> 7;
    const int L = (s < 16) ? 256 : 1024, row0 = (s < 16) ? s * 256 : NCTX + (s - 16) * 1024, nchunk = L / 16;
    f32x4 acc[8];
    if (s >= 16) { const float* st = a.in[4] + ((((size_t)(s - 16) * 2 + l) * 2 + dir) * 8 + h) * 16384;
#pragma unroll
        for (int dt = 0; dt < 8; ++dt)
#pragma unroll
            for (int jj = 0; jj < 4; ++jj) acc[dt][jj] = st[(16 * dt + 4 * fq + jj) * 128 + 16 * w + fr]; }
    else {
#pragma unroll
        for (int dt = 0; dt < 8; ++dt) acc[dt] = (f32x4){0.f, 0.f, 0.f, 0.f}; }
    const bf16_t* GK = (const bf16_t*)(a.ws + WS_GK); const bf16_t* GQ = (const bf16_t*)(a.ws + WS_GQ); const bf16_t* GV = (const bf16_t*)(a.ws + WS_GV); const float* GAB = (const float*)(a.ws + WS_GAB);
    bf16_t* OS = (bf16_t*)(a.ws + WS_OSG) + (size_t)dir * NTOK * 1024;
    LAS float* KKs = (LAS float*)(lds + GC_PRIV);
    unsigned pk_[4], pq_[4], pv_[4]; float pg_ = 0.f, pb_ = 0.f;
#define GC_ROW(c, j) (row0 + (dir ? L - 1 - (16 * (c) + (j)) : 16 * (c) + (j)))
#define GC_PREFETCH(c) do { _Pragma("unroll") for (int i = 0; i < 4; ++i) { const size_t o_ = (size_t)GC_ROW(c, 4 * part + i) * 1024 + h * 128 + d; pk_[i] = GK[o_]; pq_[i] = GQ[o_]; pv_[i] = GV[o_]; } \
        if (tid < 16) { const size_t r_ = (size_t)GC_ROW(c, tid) * 32; pg_ = GAB[r_ + dir * 8 + h]; pb_ = GAB[r_ + 16 + dir * 8 + h]; } } while (0)
#define GC_TSTAGE(Bp) do { LAS unsigned char* Bt_ = (Bp); \
        const LAS float* GCa_ = (const LAS float*)(Bt_ + GC_GC); const LAS float* BSa_ = (const LAS float*)(Bt_ + GC_BS); \
        f32x4 Gm_ = (f32x4){0.f, 0.f, 0.f, 0.f}, Aq_ = Gm_; \
        _Pragma("unroll") for (int ks = 0; ks < 4; ++ks) { const bf16x8 kfr_ = *(const LAS bf16x8*)(Bt_ + GC_KT + fr * 272 + 64 * ks + 16 * fq), qfr_ = *(const LAS bf16x8*)(Bt_ + GC_QT + fr * 272 + 64 * ks + 16 * fq); \
            Gm_ = __builtin_amdgcn_mfma_f32_16x16x32_bf16(kfr_, kfr_, Gm_, 0, 0, 0); Aq_ = __builtin_amdgcn_mfma_f32_16x16x32_bf16(kfr_, qfr_, Aq_, 0, 0, 0); } \
        const float gct_ = GCa_[fr], bet_ = BSa_[fr]; const f32x4 gc4_ = *(const LAS f32x4*)(GCa_ + 4 * fq); \
        f32x4 KK_; \
        _Pragma("unroll") for (int jj = 0; jj < 4; ++jj) { const float dec_ = __expf(fminf(gct_ - gc4_[jj], 0.f)); const int sidx_ = 4 * fq + jj; \
            KK_[jj] = (sidx_ < fr) ? bet_ * Gm_[jj] * dec_ : 0.f; Aq_[jj] = (sidx_ <= fr) ? Aq_[jj] * dec_ : 0.f; } \
        *(LAS f32x4*)(KKs + fr * 16 + 4 * fq) = KK_; \
        { u32x2 t_; t_.x = pk2(Aq_[0], Aq_[1]); t_.y = pk2(Aq_[2], Aq_[3]); *(LAS u32x2*)(Bt_ + GC_AQ + fr * 32 + 8 * fq) = t_; } \
        asm volatile("s_waitcnt lgkmcnt(0)" ::: "memory"); \
        float x_[16]; \
        _Pragma("unroll") for (int t = 0; t < 16; ++t) x_[t] = (t == fr) ? 1.0f : 0.0f; \
        _Pragma("unroll") for (int t = 1; t < 16; ++t) { float sa_ = 0.f; \
            _Pragma("unroll") for (int sb = 0; sb < (t + 3) / 4; ++sb) { const f32x4 kk_ = *(const LAS f32x4*)(KKs + t * 16 + 4 * sb); \
                sa_ += (kk_.x * x_[4 * sb] + kk_.y * x_[4 * sb + 1]) + (kk_.z * x_[4 * sb + 2] + kk_.w * x_[4 * sb + 3]); } \
            x_[t] -= sa_; } \
        _Pragma("unroll") for (int e = 0; e < 4; e += 2) { \
            const float ta_ = (fq == 0) ? x_[e] : ((fq == 1) ? x_[4 + e] : ((fq == 2) ? x_[8 + e] : x_[12 + e])); \
            const float tb_ = (fq == 0) ? x_[e + 1] : ((fq == 1) ? x_[5 + e] : ((fq == 2) ? x_[9 + e] : x_[13 + e])); \
            const unsigned tp_ = pk2(ta_, tb_); \
            ((LAS bf16_t*)(Bt_ + GC_TT))[(4 * fq + e) * 16 + fr] = (bf16_t)(tp_ & 0xffffu); ((LAS bf16_t*)(Bt_ + GC_TT))[(4 * fq + e + 1) * 16 + fr] = (bf16_t)(tp_ >> 16); } \
    } while (0)
    GC_PREFETCH(0);
    float kf[4];
    { LAS unsigned char* B = lds;
#pragma unroll
        for (int i = 0; i < 4; ++i) { kf[i] = __builtin_bit_cast(float, pk_[i] << 16);
            ((LAS bf16_t*)(B + GC_KT))[(4 * part + i) * 136 + d] = (bf16_t)pk_[i];
            ((LAS bf16_t*)(B + GC_QT))[(4 * part + i) * 136 + d] = (bf16_t)pq_[i];
            ((LAS float*)(B + GC_V))[(4 * part + i) * 128 + d] = __builtin_bit_cast(float, pv_[i] << 16); }
        if (tid < 16) { ((LAS float*)(B + GC_GS))[tid] = pg_; ((LAS float*)(B + GC_BS))[tid] = pb_; }
        if (1 < nchunk) GC_PREFETCH(1);
        LDS_BARRIER();
        { const LAS float* GS = (const LAS float*)(B + GC_GS);
          const f32x4 g0 = *(const LAS f32x4*)(GS), g1 = *(const LAS f32x4*)(GS + 4), g2 = *(const LAS f32x4*)(GS + 8), g3 = *(const LAS f32x4*)(GS + 12);
          const float s0 = (g0.x + g0.y) + (g0.z + g0.w), s1 = (g1.x + g1.y) + (g1.z + g1.w), s2 = (g2.x + g2.y) + (g2.z + g2.w), s3 = (g3.x + g3.y) + (g3.z + g3.w);
          const float glast = (s0 + s1) + (s2 + s3);
          { const float pre = (part > 0 ? s0 : 0.f) + (part > 1 ? s1 : 0.f) + (part > 2 ? s2 : 0.f);
            const f32x4 gl = *(const LAS f32x4*)(GS + 4 * part);
            const float c0 = pre + gl.x, c1 = c0 + gl.y, c2 = c1 + gl.z, c3 = c2 + gl.w;
            u32x2 t; t.x = pk2(kf[0] * __expf(glast - c0), kf[1] * __expf(glast - c1)); t.y = pk2(kf[2] * __expf(glast - c2), kf[3] * __expf(glast - c3));
            *(LAS u32x2*)(B + GC_KD + d * 80 + 8 * part) = t; }
          if (tid < 16) { const int p2 = tid >> 2, i2 = tid & 3;
            const float pre = (p2 > 0 ? s0 : 0.f) + (p2 > 1 ? s1 : 0.f) + (p2 > 2 ? s2 : 0.f);
            const f32x4 gl = *(const LAS f32x4*)(GS + 4 * p2);
            const float c0 = pre + gl.x, c1 = c0 + gl.y, c2 = c1 + gl.z, c3 = c2 + gl.w;
            const float gcv = (i2 == 0) ? c0 : ((i2 == 1) ? c1 : ((i2 == 2) ? c2 : c3));
            ((LAS float*)(B + GC_GC))[tid] = gcv; ((LAS float*)(B + GC_EG))[tid] = __expf(gcv); } }
        if (w == 0) GC_TSTAGE(B);
        LDS_BARRIER(); }
    for (int c = 0; c < nchunk; ++c) {
        const bool hn = c + 1 < nchunk;
        if (hn) { LAS unsigned char* B = lds + ((c + 1) & 1) * GC_BUF;
#pragma unroll
        for (int i = 0; i < 4; ++i) { kf[i] = __builtin_bit_cast(float, pk_[i] << 16);
            ((LAS bf16_t*)(B + GC_KT))[(4 * part + i) * 136 + d] = (bf16_t)pk_[i];
            ((LAS bf16_t*)(B + GC_QT))[(4 * part + i) * 136 + d] = (bf16_t)pq_[i];
            ((LAS float*)(B + GC_V))[(4 * part + i) * 128 + d] = __builtin_bit_cast(float, pv_[i] << 16); }
        if (tid < 16) { ((LAS float*)(B + GC_GS))[tid] = pg_; ((LAS float*)(B + GC_BS))[tid] = pb_; }
            if (c + 2 < nchunk) GC_PREFETCH(c + 2); }
        LDS_BARRIER();
        if (hn) { LAS unsigned char* B = lds + ((c + 1) & 1) * GC_BUF;
        { const LAS float* GS = (const LAS float*)(B + GC_GS);
          const f32x4 g0 = *(const LAS f32x4*)(GS), g1 = *(const LAS f32x4*)(GS + 4), g2 = *(const LAS f32x4*)(GS + 8), g3 = *(const LAS f32x4*)(GS + 12);
          const float s0 = (g0.x + g0.y) + (g0.z + g0.w), s1 = (g1.x + g1.y) + (g1.z + g1.w), s2 = (g2.x + g2.y) + (g2.z + g2.w), s3 = (g3.x + g3.y) + (g3.z + g3.w);
          const float glast = (s0 + s1) + (s2 + s3);
          { const float pre = (part > 0 ? s0 : 0.f) + (part > 1 ? s1 : 0.f) + (part > 2 ? s2 : 0.f);
            const f32x4 gl = *(const LAS f32x4*)(GS + 4 * part);
            const float c0 = pre + gl.x, c1 = c0 + gl.y, c2 = c1 + gl.z, c3 = c2 + gl.w;
            u32x2 t; t.x = pk2(kf[0] * __expf(glast - c0), kf[1] * __expf(glast - c1)); t.y = pk2(kf[2] * __expf(glast - c2), kf[3] * __expf(glast - c3));
            *(LAS u32x2*)(B + GC_KD + d * 80 + 8 * part) = t; }
          if (tid < 16) { const int p2 = tid >> 2, i2 = tid & 3;
            const float pre = (p2 > 0 ? s0 : 0.f) + (p2 > 1 ? s1 : 0.f) + (p2 > 2 ? s2 : 0.f);
            const f32x4 gl = *(const LAS f32x4*)(GS + 4 * p2);
            const float c0 = pre + gl.x, c1 = c0 + gl.y, c2 = c1 + gl.z, c3 = c2 + gl.w;
            const float gcv = (i2 == 0) ? c0 : ((i2 == 1) ? c1 : ((i2 == 2) ? c2 : c3));
            ((LAS float*)(B + GC_GC))[tid] = gcv; ((LAS float*)(B + GC_EG))[tid] = __expf(gcv); } }
        if (w == 0) GC_TSTAGE(B);
        }
        { LAS unsigned char* B = lds + (c & 1) * GC_BUF;
        const LAS float* EGa = (const LAS float*)(B + GC_EG); const LAS float* BSa = (const LAS float*)(B + GC_BS);
        const f32x4 eg4 = *(const LAS f32x4*)(EGa + 4 * fq), be4 = *(const LAS f32x4*)(BSa + 4 * fq);
        const float egl = EGa[15];
        u32x4 af; { const u32x2 t = *(const LAS u32x2*)(B + GC_AQ + fr * 32 + 8 * fq); af.x = t.x; af.y = t.y; af.z = 0u; af.w = 0u; }
        u32x4 tf; { const u32x2 t = *(const LAS u32x2*)(B + GC_TT + fr * 32 + 8 * fq); tf.x = t.x; tf.y = t.y; tf.z = 0u; tf.w = 0u; }
        f32x4 P = (f32x4){0.f, 0.f, 0.f, 0.f}, QS = P;
#pragma unroll
        for (int ks = 0; ks < 4; ++ks) {
            const u32x2 ka = *(const LAS u32x2*)(B + GC_KT + fr * 272 + 64 * ks + 8 * fq), kb = *(const LAS u32x2*)(B + GC_KT + fr * 272 + 64 * ks + 32 + 8 * fq);
            const u32x2 qa = *(const LAS u32x2*)(B + GC_QT + fr * 272 + 64 * ks + 8 * fq), qb = *(const LAS u32x2*)(B + GC_QT + fr * 272 + 64 * ks + 32 + 8 * fq);
            u32x4 k2; k2.x = ka.x; k2.y = ka.y; k2.z = kb.x; k2.w = kb.y; u32x4 q2; q2.x = qa.x; q2.y = qa.y; q2.z = qb.x; q2.w = qb.y;
            u32x4 sf; sf.x = pk2(acc[2 * ks][0], acc[2 * ks][1]); sf.y = pk2(acc[2 * ks][2], acc[2 * ks][3]); sf.z = pk2(acc[2 * ks + 1][0], acc[2 * ks + 1][1]); sf.w = pk2(acc[2 * ks + 1][2], acc[2 * ks + 1][3]);
            P = __builtin_amdgcn_mfma_f32_16x16x32_bf16(__builtin_bit_cast(bf16x8, k2), __builtin_bit_cast(bf16x8, sf), P, 0, 0, 0);
            QS = __builtin_amdgcn_mfma_f32_16x16x32_bf16(__builtin_bit_cast(bf16x8, q2), __builtin_bit_cast(bf16x8, sf), QS, 0, 0, 0); }
        float Rr[4];
#pragma unroll
        for (int jj = 0; jj < 4; ++jj) { const float vv = ((const LAS float*)(B + GC_V))[(4 * fq + jj) * 128 + 16 * w + fr]; Rr[jj] = be4[jj] * (vv - eg4[jj] * P[jj]); }
        u32x4 rf; rf.x = pk2(Rr[0], Rr[1]); rf.y = pk2(Rr[2], Rr[3]); rf.z = 0u; rf.w = 0u;
        const f32x4 vn = __builtin_amdgcn_mfma_f32_16x16x32_bf16(__builtin_bit_cast(bf16x8, tf), __builtin_bit_cast(bf16x8, rf), (f32x4){0.f, 0.f, 0.f, 0.f}, 0, 0, 0);
        u32x4 vf; vf.x = pk2(vn[0], vn[1]); vf.y = pk2(vn[2], vn[3]); vf.z = 0u; vf.w = 0u;
        const f32x4 oi = __builtin_amdgcn_mfma_f32_16x16x32_bf16(__builtin_bit_cast(bf16x8, af), __builtin_bit_cast(bf16x8, vf), (f32x4){0.f, 0.f, 0.f, 0.f}, 0, 0, 0);
#pragma unroll
        for (int jj = 0; jj < 4; jj += 2) { const unsigned op = pk2(eg4[jj] * QS[jj] + oi[jj], eg4[jj + 1] * QS[jj + 1] + oi[jj + 1]);
            OS[(size_t)GC_ROW(c, 4 * fq + jj) * 1024 + h * 128 + 16 * w + fr] = (bf16_t)(op & 0xffffu); OS[(size_t)GC_ROW(c, 4 * fq + jj + 1) * 1024 + h * 128 + 16 * w + fr] = (bf16_t)(op >> 16); }
#pragma unroll
        for (int dt = 0; dt < 8; ++dt) {
            u32x4 kdf; { const u32x2 t = *(const LAS u32x2*)(B + GC_KD + (16 * dt + fr) * 80 + 8 * fq); kdf.x = t.x; kdf.y = t.y; kdf.z = 0u; kdf.w = 0u; }
            acc[dt] = __builtin_amdgcn_mfma_f32_16x16x32_bf16(__builtin_bit_cast(bf16x8, kdf), __builtin_bit_cast(bf16x8, vf), acc[dt] * egl, 0, 0, 0); }
        }
        LDS_BARRIER();
    }
#undef GC_ROW
#undef GC_PREFETCH
#undef GC_TSTAGE
    if (s < 16) { float* so = a.out + OUT_SGDN + ((((size_t)s * 2 + l) * 2 + dir) * 8 + h) * 16384;
#pragma unroll
        for (int dt = 0; dt < 8; ++dt)
#pragma unroll
            for (int jj = 0; jj < 4; ++jj) so[(16 * dt + 4 * fq + jj) * 128 + 16 * w + fr] = acc[dt][jj]; }
    __syncthreads();
}

__device__ __forceinline__ void gmlp_item(KArgs& a, LAS unsigned char* lds, int l, int chunk, int g) {
    const int tid = otid(), lane = tid & 63, w = tid >> 6, row0 = chunk * 128;
    LAS bf16_t* vT = (LAS bf16_t*)lds;
    { const int q = tid >> 2, part = tid & 3;
      const bf16_t* src = (const bf16_t*)(a.ws + WS_CV) + (size_t)(row0 + q) * 1024 + g * 128 + part * 32;
      float x[32]; float ss = 0.f;
#pragma unroll
      for (int i = 0; i < 4; ++i) { const u32x4 r = ((const u32x4*)src)[i];
          x[8 * i] = bf_lo(r.x); x[8 * i + 1] = bf_hi(r.x); x[8 * i + 2] = bf_lo(r.y); x[8 * i + 3] = bf_hi(r.y); x[8 * i + 4] = bf_lo(r.z); x[8 * i + 5] = bf_hi(r.z); x[8 * i + 6] = bf_lo(r.w); x[8 * i + 7] = bf_hi(r.w); }
#pragma unroll
      for (int i = 0; i < 32; ++i) ss += x[i] * x[i];
      ss += __shfl_xor(ss, 1); ss += __shfl_xor(ss, 2);
      const float rstd = rsqrtf(ss * (1.0f / 128.0f) + EPS);
      const float* gn = a.in[13] + l * 1024 + g * 128 + part * 32;
#pragma unroll
      for (int i = 0; i < 32; ++i) vT[(part * 32 + i) * 136 + q] = (bf16_t)f2bf(x[i] * rstd * gn[i]);
    }
    __syncthreads();
    const int fr = lane & 15, fq = lane >> 4, p = 16 * w + fr;
    const float* wsrow = a.in[14] + (((size_t)l * 8 + g) * 128 + p) * 128;
    bf16x8 bw[4];
#pragma unroll
    for (int ks = 0; ks < 4; ++ks) { const f32x4 x0 = *(const f32x4*)(wsrow + ks * 32 + 8 * fq), x1 = *(const f32x4*)(wsrow + ks * 32 + 8 * fq + 4);
        u32x4 t; t.x = pk2(x0.x, x0.y); t.y = pk2(x0.z, x0.w); t.z = pk2(x1.x, x1.y); t.w = pk2(x1.z, x1.w); bw[ks] = __builtin_bit_cast(bf16x8, t); }
    const float bias = a.in[15][((size_t)l * 8 + g) * 128 + p];
    const bf16_t* CU = (const bf16_t*)(a.ws + WS_CU); bf16_t* OB = (bf16_t*)(a.ws + WS_OB);
#pragma unroll
    for (int ct = 0; ct < 8; ++ct) {
        f32x4 acc = (f32x4){0.f, 0.f, 0.f, 0.f};
#pragma unroll
        for (int ks = 0; ks < 4; ++ks) { const bf16x8 av = *(const LAS bf16x8*)(vT + (ct * 16 + fr) * 136 + ks * 32 + 8 * fq);
            acc = __builtin_amdgcn_mfma_f32_16x16x32_bf16(av, bw[ks], acc, 0, 0, 0); }
        const size_t o = (size_t)(row0 + p) * 1024 + g * 128 + ct * 16 + 4 * fq;
        const u32x2 uu = *(const u32x2*)(CU + o);
        u32x2 r; r.x = pk2(bf_lo(uu.x) * (acc[0] + bias), bf_hi(uu.x) * (acc[1] + bias)); r.y = pk2(bf_lo(uu.y) * (acc[2] + bias), bf_hi(uu.y) * (acc[3] + bias));
        *(u32x2*)(OB + o) = r;
    }
    __syncthreads();
}

__device__ __forceinline__ void phase_mixers(KArgs& a, LAS unsigned char* lds, int lq) {
    const int l = lq & 1;
    unsigned* head = (unsigned*)(a.ws + WS_CTL) + CW_QUEUE + 64 * lq;
    volatile LAS unsigned* slot = (volatile LAS unsigned*)(lds + LDS_MISC);
    for (;;) {
        if (otid() == 0) slot[0] = __hip_atomic_fetch_add(head, 1u, __ATOMIC_RELAXED, __HIP_MEMORY_SCOPE_AGENT);
        __syncthreads();
        int idx = (int)slot[0];
        __syncthreads();
        {
            const int nsup = l ? BG1_SUPER : BG0_SUPER;
            if (idx >= 1152 + nsup) break;
            if (idx >= 128) { const int r = idx - 128;
                if (r < 2 * nsup) { if (r & 1) { conv_super_item(a, lds, l ? BG1_FIRST : BG0_FIRST, l ? BG1_END : BG0_END, r >> 1); continue; } idx = 128 + (r >> 1); }
                else idx = 128 + nsup + (r - 2 * nsup); }
        }
        if (idx < 640) {
            const bool lat = idx < 128; const int j = lat ? idx : idx - 128; const bool gdn = lat ? (j < 64) : (j < 256);
            const int jj = lat ? (j & 63) : (gdn ? j : j - 256); const int s = lat ? 16 + (jj >> 4) : (jj >> 4); const int rem = jj & 15;
            if (gdn) gdn_chunk_item(a, lds, l, s, rem >> 1, rem & 1); else hgrn_chunk_item(a, lds, l, s, rem >> 1, rem & 1);
        } else { const int j = idx - 640; gmlp_item(a, lds, l, j >> 3, j & 7); }
    }
}

__device__ __forceinline__ void phase_onorm(KArgs& a, int l) {
    const int tid = otid(), lane = tid & 63, wave = tid >> 6, gw = blockIdx.x * 8 + wave, NGW = gridDim.x * 8;
    const int sub = lane >> 4, l16 = lane & 15;
    for (int it = gw * 4 + sub; it < NTOK * 16; it += NGW * 4) {
        const int br = it & 1, rh = it >> 1, r = rh >> 3, h = rh & 7;
        const bf16_t* OS = (const bf16_t*)(a.ws + (br ? WS_OSG : WS_OSH)); const size_t o = (size_t)r * 1024 + h * 128 + 8 * l16;
        const u32x4 w0 = *(const u32x4*)(OS + o), w1 = *(const u32x4*)(OS + (size_t)NTOK * 1024 + o);
        const u32x4 gg = *(const u32x4*)((const bf16_t*)(a.ws + (br ? WS_GGO : WS_HGO)) + o);
        const float* gnp = a.in[br ? 19 : 12] + l * 128 + 8 * l16; const f32x4 g0 = *(const f32x4*)gnp, g1 = *(const f32x4*)(gnp + 4);
        float y[8] = {bf_lo(w0.x) + bf_lo(w1.x), bf_hi(w0.x) + bf_hi(w1.x), bf_lo(w0.y) + bf_lo(w1.y), bf_hi(w0.y) + bf_hi(w1.y),
                      bf_lo(w0.z) + bf_lo(w1.z), bf_hi(w0.z) + bf_hi(w1.z), bf_lo(w0.w) + bf_lo(w1.w), bf_hi(w0.w) + bf_hi(w1.w)};
        float ss = 0.f;
#pragma unroll
        for (int e = 0; e < 8; ++e) ss += y[e] * y[e];
        const float rstd = rsqrtf(red16(ss) * (1.0f / 128.0f) + EPS);
        u32x4 out;
        out.x = pk2(y[0] * rstd * g0.x * bf_lo(gg.x), y[1] * rstd * g0.y * bf_hi(gg.x)); out.y = pk2(y[2] * rstd * g0.z * bf_lo(gg.y), y[3] * rstd * g0.w * bf_hi(gg.y));
        out.z = pk2(y[4] * rstd * g1.x * bf_lo(gg.z), y[5] * rstd * g1.y * bf_hi(gg.z)); out.w = pk2(y[6] * rstd * g1.z * bf_lo(gg.w), y[7] * rstd * g1.w * bf_hi(gg.w));
        *(u32x4*)((bf16_t*)(a.ws + (br ? WS_OC : WS_OA)) + o) = out;
    }
}

#define XB_TMO      128
#define XB_XCNT(j)  (256  + 64 * (j))
#define XB_XSUB(j)  (1280 + 64 * (j))
#define XB_XGEN(j)  (2304 + 64 * (j))
#define XB_TOP      3328
#define XB_TOPGEN   3392
#define XCD_BAR_WORDS 3456
#define XB_SPIN_CAP (1u << 18)

__device__ __forceinline__ unsigned xb_ld(unsigned* p)              { return __hip_atomic_load(p, __ATOMIC_RELAXED, __HIP_MEMORY_SCOPE_AGENT); }
__device__ __forceinline__ unsigned xb_add(unsigned* p, unsigned v) { return __hip_atomic_fetch_add(p, v, __ATOMIC_RELAXED, __HIP_MEMORY_SCOPE_AGENT); }
__device__ __forceinline__ unsigned xb_xcc_id() { return (unsigned)__builtin_amdgcn_s_getreg((3 << 11) | 20) & 0xFu; }
#define XB_SPIN(cond, bar) do { unsigned _sp = 0; while (cond) { __builtin_amdgcn_s_sleep(1); \
    if ((++_sp & 255u) == 0u) { if (xb_ld(&(bar)[XB_TMO])) break; if (_sp > XB_SPIN_CAP) { atomicAdd(&(bar)[XB_TMO], 1u); break; } } } } while (0)

struct XcdBarrier {
    unsigned* bar; unsigned x;
    volatile LAS unsigned* st;
};

__device__ __forceinline__ XcdBarrier xcd_barrier_post(unsigned* bar, volatile LAS unsigned* st) {
    XcdBarrier b; b.bar = bar; b.x = xb_xcc_id(); b.st = st;
    if (threadIdx.x == 0) (void)xb_add(&bar[XB_XCNT(b.x)], 1u);
    return b;
}
__device__ __forceinline__ void xcd_barrier_complete(unsigned* bar, unsigned x, unsigned& nloc, unsigned& nx) {
    const unsigned G = gridDim.x * gridDim.y * gridDim.z;
    unsigned sum, cnt, mine, sp = 0u;
    for (;;) {
        sum = 0u; cnt = 0u; mine = 0u;
#pragma unroll
        for (unsigned j = 0; j < 16; ++j) { const unsigned c = xb_ld(&bar[XB_XCNT(j)]); sum += c; cnt += (c > 0u) ? 1u : 0u; mine = (j == x) ? c : mine; }
        if (sum == G) break;
        __builtin_amdgcn_s_sleep(1);
        if ((++sp & 255u) == 0u) { if (xb_ld(&bar[XB_TMO])) break; if (sp > XB_SPIN_CAP) { atomicAdd(&bar[XB_TMO], 1u); break; } }
    }
    nloc = mine > 0u ? mine : 1u; nx = cnt > 0u ? cnt : 1u;
}

__device__ __forceinline__ void xcd_barrier(const XcdBarrier& b) {
    asm volatile("s_waitcnt vmcnt(0)" ::: "memory");
    __syncthreads();
    if (threadIdx.x == 0) {
        unsigned* bar = b.bar;
        __builtin_amdgcn_s_waitcnt(0);
        unsigned nloc = b.st[0], nx = b.st[1];
        if (nloc == 0u) { xcd_barrier_complete(bar, b.x, nloc, nx); b.st[0] = nloc; b.st[1] = nx; }
        const unsigned old = xb_add(&bar[XB_XSUB(b.x)], 1u);
        const unsigned gen = old / nloc;
        if (old + 1u == (gen + 1u) * nloc) {
            __builtin_amdgcn_fence(__ATOMIC_RELEASE, "agent");
            asm volatile("s_waitcnt vmcnt(0)" ::: "memory");
            const unsigned og = xb_add(&bar[XB_TOP], 1u);
            const unsigned tg = og / nx;
            if (og + 1u == (tg + 1u) * nx) xb_add(&bar[XB_TOPGEN], 1u);
            else XB_SPIN(xb_ld(&bar[XB_TOPGEN]) == tg, bar);
            __builtin_amdgcn_fence(__ATOMIC_ACQUIRE, "agent");
            xb_add(&bar[XB_XGEN(b.x)], 1u);
            asm volatile("s_waitcnt vmcnt(0)" ::: "memory");
        } else {
            XB_SPIN(xb_ld(&bar[XB_XGEN(b.x)]) == gen, bar);
            __builtin_amdgcn_fence(__ATOMIC_ACQUIRE, "agent");
            asm volatile("s_waitcnt vmcnt(0)" ::: "memory");
        }
    }
    __syncthreads();
}


__device__ __forceinline__ void run_phase(LAS unsigned char* lds, int ph, int rep) {
    KArgs& a = *get_args();
#ifndef DIAG_ONLY
    if (ph == 0) { phase_prologue(a, lds); return; }
    if (ph == 21) { phase_final_norm(a); return; }
#else
    if (ph == 0 || ph == 21) { if (DIAG_ONLY == 10) phase_prologue(a, lds); return; }
#endif
    const int l = (ph - 1) / 10, k = (ph - 1) % 10;
    unsigned char* wl = a.ws + WS_W + (size_t)l * W_LSTRIDE;
    const int G = gridDim.x, c = blockIdx.x;
#ifdef DIAG_ONLY
    if (k != DIAG_ONLY) return;
#endif
    switch (k) {
    case 0: phase_norm_mod(a, l, 0); break;
    case 1: { pg8::Gemm g{(const bf16_t*)(a.ws + WS_H), (const bf16_t*)(wl + W_IN), NTOK, IN_PAD, D}; pg8::StaticOrder S; S.init(NTOK, IN_PAD, G, c);
              EpiIn E{a.ws, a.in[11], a.in[17], a.in[18], l}; pg8::gemm_phase<EpiIn, pg8::StaticOrder, true, true>(lds, g, S, E); } break;
    case 2: phase_gdn_prep(a, l); break;
    case 3: phase_mixers(a, lds, l + 2 * rep); break;
    case 4: phase_onorm(a, l); break;
    case 5: { pg8::Gemm g{(const bf16_t*)(a.ws + WS_OA), (const bf16_t*)(wl + W_BR), 3 * NTOK, 3 * D, 1024};
              Br3Order S; S.base.init(NTOK, D, G, c); EpiBr3 E{a.ws}; pg8::gemm_phase<EpiBr3, Br3Order, true, true>(lds, g, S, E); } break;
    case 6: { pg8::Gemm g{(const bf16_t*)(a.ws + WS_MERGED), (const bf16_t*)(wl + W_OUT), NTOK, D, D}; pg8::StaticOrder S; S.init(NTOK, D, G, c);
              EpiRes E{a.ws, l, 4096}; pg8::gemm_phase<EpiRes, pg8::StaticOrder, true, true>(lds, g, S, E); } break;
    case 7: phase_norm_mod(a, l, 1); break;
    case 8: { pg8::Gemm g{(const bf16_t*)(a.ws + WS_H), (const bf16_t*)(wl + W_FF1), NTOK, DFF, D}; pg8::StaticOrder S; S.init(NTOK, DFF, G, c);
              EpiRelu2 E{a.ws}; pg8::gemm_phase<EpiRelu2, pg8::StaticOrder, true, true>(lds, g, S, E); } break;
    case 9: { pg8::Gemm g{(const bf16_t*)(a.ws + WS_FFH), (const bf16_t*)(wl + W_FF2), NTOK, D, DFF}; pg8::StaticOrder S; S.init(NTOK, D, G, c);
              EpiRes E{a.ws, l, 10240}; pg8::gemm_phase<EpiRes, pg8::StaticOrder, true, true>(lds, g, S, E); } break;
    }
}

#ifndef PROBE_REPEAT_K
#define PROBE_REPEAT_K (-1)
#endif
__global__ void __launch_bounds__(NTHR, 2) fwd_megakernel(Args args) {
    extern __shared__ __attribute__((aligned(16))) unsigned char lds_raw[];
    LAS unsigned char* lds = (LAS unsigned char*)lds_raw;
#if MK_MULTI
    for (int ph = args.ph_lo; ph < args.ph_hi; ++ph) { run_phase(lds, ph, 0); __syncthreads(); }
#else
    cg::grid_group grid = cg::this_grid();
    volatile LAS unsigned* misc = (volatile LAS unsigned*)(lds + LDS_MISC);
    if (threadIdx.x < 16) misc[threadIdx.x] = 0u;
    __syncthreads();
    XcdBarrier bar = xcd_barrier_post((unsigned*)(args.ws + WS_CTL) + CW_BAR, misc + 8);
    grid.sync();
#pragma unroll 1
    for (int ph = args.ph_lo; ph < args.ph_hi; ++ph) {
        run_phase(lds, ph, 0);
        if (PROBE_REPEAT_K != -1 && ((PROBE_REPEAT_K == -2 && ph == 0) || (ph >= 1 && ph <= 20 && (ph - 1) % 10 == PROBE_REPEAT_K))) { xcd_barrier(bar); run_phase(lds, ph, 1); }
        if (ph + 1 < args.ph_hi) {
            xcd_barrier(bar);
        }
    }
#endif
}

extern "C" void kernel_launch(void* const* d_in, const int* in_sizes, int n_in, void* d_out, int out_size, void* d_ws, size_t ws_size, hipStream_t stream) {
    static int grid = 0;
    if (grid == 0) {
        int dev = 0, cus = 0, per_cu = 0;
        if (n_in != 27 || ws_size < WS_END) { fprintf(stderr, "kernel_launch: unexpected n_in %d or ws_size %zu (< %zu)\n", n_in, ws_size, (size_t)WS_END); grid = -1; return; }
        if (hipGetDevice(&dev) != hipSuccess || hipDeviceGetAttribute(&cus, hipDeviceAttributeMultiprocessorCount, dev) != hipSuccess) { grid = -1; return; }
        if (hipFuncSetAttribute((const void*)fwd_megakernel, hipFuncAttributeMaxDynamicSharedMemorySize, LDS_BYTES) != hipSuccess) { fprintf(stderr, "kernel_launch: hipFuncSetAttribute failed\n"); grid = -1; return; }
        if (hipOccupancyMaxActiveBlocksPerMultiprocessor(&per_cu, (const void*)fwd_megakernel, NTHR, LDS_BYTES) != hipSuccess || per_cu < 1) { fprintf(stderr, "kernel_launch: occupancy query failed (%d)\n", per_cu); (void)hipGetLastError(); per_cu = 1; }
        grid = cus * per_cu;
    }
    if (grid < 0) return;
    (void)hipMemsetAsync((char*)d_ws + WS_CTL, 0, CTL_BYTES, stream);
    Args a{};
    for (int i = 0; i < 27; ++i) a.in[i] = (const float*)d_in[i];
    a.out = (float*)d_out; a.ws = (unsigned char*)d_ws;
#if MK_MULTI
    for (int ph = 0; ph < N_PHASES; ++ph) { a.ph_lo = ph; a.ph_hi = ph + 1; hipLaunchKernelGGL(fwd_megakernel, dim3(grid), dim3(NTHR), LDS_BYTES, stream, a); }
#else
    a.ph_lo = 0; a.ph_hi = N_PHASES;
    void* kargs[] = {(void*)&a};
    hipError_t e = hipLaunchCooperativeKernel((const void*)fwd_megakernel, dim3(grid), dim3(NTHR), kargs, LDS_BYTES, stream);
    if (e != hipSuccess) fprintf(stderr, "kernel_launch: cooperative launch failed: %s (grid %d)\n", hipGetErrorString(e), grid);
#endif
}
```
